# Optimizing an MI355X kernel written in HIP

```python
import jax, jax.numpy as jnp
from jax import lax
import numpy as np

D_MODEL = 1024
BATCH = 2
SEQ = 16384
DEPTH = 2

HEAD_DIM = 64
Q_BLOCK = 128
EPS = 1e-6
NEG_INF = -1e30
A_HEADS = 8
A_PATTERNS = ((128, 1), (512, 4), (2048, 16))
B_HEADS = 4
B_DK = 64
B_DV = 128
B_GATE_RANK = 16
B_GATE_TAU = 16.0
B_CHUNK = 64
C_HEADS = 8
C_KV_HEADS = 2
C_WINDOW = 128
D_HEADS = 8
D_Q_RANK = 384
D_KV_RANK = 256
D_NOPE = 64
D_ROPE = 32
D_V = 64
ROPE_BASE = 10000.0
D_FF = -(-8 * D_MODEL // (3 * 256)) * 256

L0_IN_SIZES = (A_HEADS * HEAD_DIM, A_HEADS * HEAD_DIM, A_HEADS * HEAD_DIM,
               B_HEADS * B_DK, B_HEADS * B_DK, B_HEADS * B_DV, B_HEADS * B_DV, B_GATE_RANK)
L0_IN = sum(L0_IN_SIZES)
L0_MIX = A_HEADS * HEAD_DIM + B_HEADS * B_DV
L1_IN_SIZES = (C_HEADS * HEAD_DIM, C_KV_HEADS * HEAD_DIM, C_KV_HEADS * HEAD_DIM,
               D_Q_RANK, D_KV_RANK, D_ROPE)
L1_IN = sum(L1_IN_SIZES)
L1_MIX = C_HEADS * HEAD_DIM + D_HEADS * D_V
N_EVEN = (DEPTH + 1) // 2
N_ODD = DEPTH // 2

kernel_name = "hybrid_dilated_gla_swasink_mla_block"


def rmsnorm(x, g):
    xf = x.astype(jnp.float32)
    y = xf * lax.rsqrt(jnp.mean(xf * xf, axis=-1, keepdims=True) + EPS)
    return (y * g.astype(jnp.float32)).astype(x.dtype)


def alibi_slopes(n):
    return jnp.asarray(np.array([2.0 ** (-8.0 * (i + 1) / n) for i in range(n)], dtype=np.float32))


def split_cols(t, sizes):
    return jnp.split(t, [int(c) for c in np.cumsum(sizes)[:-1]], axis=-1)


def with_prev_block(t, blk):
    lead = t.shape[:-2]
    L, dh = t.shape[-2:]
    tb = t.reshape(*lead, L // blk, blk, dh)
    prev = jnp.concatenate([jnp.zeros_like(tb[..., :1, :, :]), tb[..., :-1, :, :]], axis=-3)
    return jnp.concatenate([prev, tb], axis=-2)


def band_geometry(nb, blk, max_rel):
    i = jnp.arange(blk)[:, None]
    j = jnp.arange(2 * blk)[None, :]
    rel = i + blk - j
    key_pos = jnp.arange(nb)[:, None, None] * blk + j - blk
    valid = (rel >= 0) & (rel <= max_rel) & (key_pos >= 0)
    return rel.astype(jnp.float32), valid


def rope(t, pos):
    half = t.shape[-1] // 2
    freqs = ROPE_BASE ** (-jnp.arange(half, dtype=jnp.float32) / half)
    ang = pos.astype(jnp.float32)[:, None] * freqs[None, :]
    cos, sin = jnp.cos(ang)[:, None, :], jnp.sin(ang)[:, None, :]
    tf = t.astype(jnp.float32)
    t1, t2 = tf[..., :half], tf[..., half:]
    return jnp.concatenate([t1 * cos - t2 * sin, t2 * cos + t1 * sin], axis=-1).astype(t.dtype)


def dilated_branch(q, k, v, slopes, window, dilation):
    B_, H, S, dh = q.shape
    L = S // dilation
    Lp = -(-L // Q_BLOCK) * Q_BLOCK
    nb = Lp // Q_BLOCK

    def by_residue(t):
        t = t.reshape(B_, H, L, dilation, dh).transpose(0, 1, 3, 2, 4)
        return jnp.pad(t, ((0, 0), (0, 0), (0, 0), (0, Lp - L), (0, 0)))

    qb = by_residue(q).reshape(B_, H, dilation, nb, Q_BLOCK, dh)
    kb = with_prev_block(by_residue(k), Q_BLOCK)
    vb = with_prev_block(by_residue(v), Q_BLOCK).astype(jnp.float32)
    rel, valid = band_geometry(nb, Q_BLOCK, window // dilation)
    s = jnp.einsum('bhrnid,bhrnjd->bhrnij', qb, kb, preferred_element_type=jnp.float32) * dh ** -0.5
    s = s - slopes[:, None, None, None, None] * (rel * dilation)
    s = jnp.where(valid, s, NEG_INF)
    m = s.max(-1)
    p = jnp.exp(s - m[..., None])
    den = p.sum(-1)
    o = jnp.einsum('bhrnij,bhrnjd->bhrnid', p, vb) / den[..., None]

    def back(t):
        t = t.reshape(B_, H, dilation, Lp, *t.shape[5:])[:, :, :, :L]
        t = jnp.moveaxis(t, 2, 3)
        return t.reshape(B_, H, S, *t.shape[4:])

    return back(o), back(m), back(den)


def dilated_attention(q, k, v):
    slopes = alibi_slopes(A_HEADS)
    outs, maxes, dens = zip(*[dilated_branch(q, k, v, slopes, w, d) for (w, d) in A_PATTERNS])
    m_all = jnp.stack(maxes)
    wts = jnp.stack(dens) * jnp.exp(m_all - m_all.max(0))
    return jnp.einsum('pbhs,pbhsd->bhsd', wts, jnp.stack(outs)) / wts.sum(0)[..., None]


def gla(q, k, v, r, g_low, w_gate_up, b_gate, norm_g):
    B_, S, _ = q.shape
    C = B_CHUNK
    nc = S // C
    log_a = jax.nn.log_sigmoid((g_low @ w_gate_up + b_gate).astype(jnp.float32)) / B_GATE_TAU

    def chunks(t, dh):
        return t.reshape(B_, nc, C, B_HEADS, dh).transpose(0, 3, 1, 2, 4).astype(jnp.float32)

    qc = chunks(q, B_DK) * B_DK ** -0.5
    kc = chunks(k, B_DK)
    vc = chunks(v, B_DV)
    bcum = jnp.cumsum(chunks(log_a, B_DK), axis=-2)
    b_last = bcum[..., -1:, :]
    b_mid = bcum[..., C // 2 - 1:C // 2, :]
    att = jnp.einsum('bhncd,bhnsd->bhncs', qc * jnp.exp(bcum - b_mid), kc * jnp.exp(b_mid - bcum))
    att = jnp.where(jnp.tril(jnp.ones((C, C), dtype=bool)), att, 0.0)
    o_intra = jnp.einsum('bhncs,bhnse->bhnce', att, vc)
    dS = jnp.einsum('bhnsd,bhnse->bhnde', kc * jnp.exp(b_last - bcum), vc)
    decay = jnp.exp(b_last[..., 0, :])

    def step(state, inp):
        dS_n, dec_n = inp
        return dec_n[..., None] * state + dS_n, state

    init = jnp.zeros((B_, B_HEADS, B_DK, B_DV), jnp.float32)
    _, s_prev = lax.scan(step, init, (jnp.moveaxis(dS, 2, 0), jnp.moveaxis(decay, 2, 0)))
    s_prev = jnp.moveaxis(s_prev, 0, 2)
    o_inter = jnp.einsum('bhncd,bhnde->bhnce', qc * jnp.exp(bcum), s_prev)
    o = (o_intra + o_inter).transpose(0, 2, 3, 1, 4).reshape(B_, S, B_HEADS, B_DV)
    o = rmsnorm(o, norm_g)
    o = o * jax.nn.silu(r.astype(jnp.float32)).reshape(B_, S, B_HEADS, B_DV)
    return o.reshape(B_, S, B_HEADS * B_DV)


def swa_sink_attention(q, k, v, sinks):
    B_, S, _ = q.shape
    G = C_HEADS // C_KV_HEADS
    nb = S // Q_BLOCK
    qb = q.reshape(B_, nb, Q_BLOCK, C_KV_HEADS, G, HEAD_DIM).transpose(0, 3, 4, 1, 2, 5)
    kt = k.reshape(B_, S, C_KV_HEADS, HEAD_DIM).transpose(0, 2, 1, 3)
    vt = v.reshape(B_, S, C_KV_HEADS, HEAD_DIM).transpose(0, 2, 1, 3)
    kb = with_prev_block(kt, Q_BLOCK)
    vb = with_prev_block(vt, Q_BLOCK).astype(jnp.float32)
    rel, valid = band_geometry(nb, Q_BLOCK, C_WINDOW - 1)
    slopes = alibi_slopes(C_HEADS).reshape(C_KV_HEADS, G)[:, :, None, None, None]
    s = jnp.einsum('bkgnid,bknjd->bkgnij', qb, kb, preferred_element_type=jnp.float32) * HEAD_DIM ** -0.5
    s = jnp.where(valid, s - slopes * rel, NEG_INF)
    sink = sinks.astype(jnp.float32).reshape(C_KV_HEADS, G)[:, :, None, None, None]
    m = jnp.maximum(s.max(-1, keepdims=True), sink)
    p = jnp.exp(s - m)
    den = p.sum(-1, keepdims=True) + jnp.exp(sink - m)
    o = jnp.einsum('bkgnij,bknjd->bkgnid', p / den, vb)
    return o.transpose(0, 3, 4, 1, 2, 5).reshape(B_, S, C_HEADS * HEAD_DIM)


def mla(c_q, c_kv, k_rope, q_norm, w_uq, kv_norm, w_ukv):
    B_, S, _ = c_q.shape
    pos = jnp.arange(S)
    q = (rmsnorm(c_q, q_norm) @ w_uq).reshape(B_, S, D_HEADS, D_NOPE + D_ROPE)
    kv = (rmsnorm(c_kv, kv_norm) @ w_ukv).reshape(B_, S, D_HEADS, D_NOPE + D_V)
    q_nope, q_pe = q[..., :D_NOPE], rope(q[..., D_NOPE:], pos)
    k_nope, v = kv[..., :D_NOPE], kv[..., D_NOPE:].astype(jnp.float32)
    k_pe = rope(k_rope[:, :, None, :], pos)[:, :, 0, :]
    scale = (D_NOPE + D_ROPE) ** -0.5
    nb = S // Q_BLOCK
    qn_b = q_nope.reshape(B_, nb, Q_BLOCK, D_HEADS, D_NOPE).transpose(1, 0, 2, 3, 4)
    qp_b = q_pe.reshape(B_, nb, Q_BLOCK, D_HEADS, D_ROPE).transpose(1, 0, 2, 3, 4)
    kpos = jnp.arange(S)

    def block(args):
        qn, qp, n = args
        s = (jnp.einsum('bihd,bjhd->bhij', qn, k_nope, preferred_element_type=jnp.float32)
             + jnp.einsum('bihd,bjd->bhij', qp, k_pe, preferred_element_type=jnp.float32)) * scale
        qpos = n * Q_BLOCK + jnp.arange(Q_BLOCK)
        s = jnp.where(qpos[:, None] >= kpos[None, :], s, NEG_INF)
        return jnp.einsum('bhij,bjhd->bihd', jax.nn.softmax(s, axis=-1), v)

    o = lax.map(block, (qn_b, qp_b, jnp.arange(nb)))
    return o.transpose(1, 0, 2, 3, 4).reshape(B_, S, D_HEADS * D_V)


def mix_even(h, w_in, w_out, gla_w_gate_up, gla_b_gate, gla_norm):
    B_, S, _ = h.shape
    qa, ka, va, qb, kb, vb, rb, gb = split_cols(h @ w_in, L0_IN_SIZES)
    heads = lambda t: t.reshape(B_, S, A_HEADS, HEAD_DIM).transpose(0, 2, 1, 3)
    o_a = dilated_attention(heads(qa), heads(ka), heads(va))
    o_a = o_a.transpose(0, 2, 1, 3).reshape(B_, S, A_HEADS * HEAD_DIM)
    o_b = gla(qb, kb, vb, rb, gb, gla_w_gate_up, gla_b_gate, gla_norm)
    return jnp.concatenate([o_a, o_b], axis=-1).astype(h.dtype) @ w_out


def mix_odd(h, w_in, w_out, sinks, q_norm, w_uq, kv_norm, w_ukv):
    qc, kc, vc, c_q, c_kv, k_rope = split_cols(h @ w_in, L1_IN_SIZES)
    o_c = swa_sink_attention(qc, kc, vc, sinks)
    o_d = mla(c_q, c_kv, k_rope, q_norm, w_uq, kv_norm, w_ukv)
    return jnp.concatenate([o_c, o_d], axis=-1).astype(h.dtype) @ w_out


def swiglu(h, w_gate, w_up, w_down):
    return (jax.nn.silu(h @ w_gate) * (h @ w_up)) @ w_down


def setup_inputs(seed: int = 0) -> dict:
    key = jax.random.key(seed)
    ks = jax.random.split(key, 24)
    nrm = lambda k, shape, fan_in: jax.random.normal(k, shape, jnp.float32) * fan_in ** -0.5
    gain = lambda k, shape: 1.0 + 0.02 * jax.random.normal(k, shape, jnp.float32)
    return {
        "x": jax.random.normal(ks[0], (BATCH, SEQ, D_MODEL), jnp.float32),
        "norm_mix_pre": gain(ks[1], (DEPTH, D_MODEL)),
        "norm_mix_post": gain(ks[2], (DEPTH, D_MODEL)),
        "norm_ffn_pre": gain(ks[3], (DEPTH, D_MODEL)),
        "norm_ffn_post": gain(ks[4], (DEPTH, D_MODEL)),
        "ffn_w_gate": nrm(ks[5], (DEPTH, D_MODEL, D_FF), D_MODEL),
        "ffn_w_up": nrm(ks[6], (DEPTH, D_MODEL, D_FF), D_MODEL),
        "ffn_w_down": nrm(ks[7], (DEPTH, D_FF, D_MODEL), D_FF),
        "ab_w_in": nrm(ks[8], (N_EVEN, D_MODEL, L0_IN), D_MODEL),
        "ab_w_out": nrm(ks[9], (N_EVEN, L0_MIX, D_MODEL), L0_MIX),
        "gla_w_gate_up": nrm(ks[10], (N_EVEN, B_GATE_RANK, B_HEADS * B_DK), B_GATE_RANK),
        "gla_b_gate": 0.1 * jax.random.normal(ks[11], (N_EVEN, B_HEADS * B_DK), jnp.float32),
        "gla_norm": gain(ks[12], (N_EVEN, B_DV)),
        "cd_w_in": nrm(ks[13], (N_ODD, D_MODEL, L1_IN), D_MODEL),
        "cd_w_out": nrm(ks[14], (N_ODD, L1_MIX, D_MODEL), L1_MIX),
        "swa_sinks": jax.random.normal(ks[15], (N_ODD, C_HEADS), jnp.float32),
        "mla_q_norm": gain(ks[16], (N_ODD, D_Q_RANK)),
        "mla_w_uq": nrm(ks[17], (N_ODD, D_Q_RANK, D_HEADS * (D_NOPE + D_ROPE)), D_Q_RANK),
        "mla_kv_norm": gain(ks[18], (N_ODD, D_KV_RANK)),
        "mla_w_ukv": nrm(ks[19], (N_ODD, D_KV_RANK, D_HEADS * (D_NOPE + D_V)), D_KV_RANK),
    }


def reference(x, norm_mix_pre, norm_mix_post, norm_ffn_pre, norm_ffn_post,
              ffn_w_gate, ffn_w_up, ffn_w_down,
              ab_w_in, ab_w_out, gla_w_gate_up, gla_b_gate, gla_norm,
              cd_w_in, cd_w_out, swa_sinks, mla_q_norm, mla_w_uq, mla_kv_norm, mla_w_ukv):
    for layer in range(DEPTH):
        i = layer // 2
        h = rmsnorm(x, norm_mix_pre[layer])
        if layer % 2 == 0:
            y = mix_even(h, ab_w_in[i], ab_w_out[i], gla_w_gate_up[i], gla_b_gate[i], gla_norm[i])
        else:
            y = mix_odd(h, cd_w_in[i], cd_w_out[i], swa_sinks[i], mla_q_norm[i], mla_w_uq[i],
                        mla_kv_norm[i], mla_w_ukv[i])
        x = x + rmsnorm(y, norm_mix_post[layer]).astype(x.dtype)
        h = rmsnorm(x, norm_ffn_pre[layer])
        f = swiglu(h, ffn_w_gate[layer], ffn_w_up[layer], ffn_w_down[layer])
        x = x + rmsnorm(f, norm_ffn_post[layer]).astype(x.dtype)
    return x
```

```cpp
#include <hip/hip_runtime.h>
#include <hip/hip_cooperative_groups.h>
#include <cstdio>
namespace cg = cooperative_groups;

typedef unsigned short bf16_t;
using bf16x8 = __attribute__((ext_vector_type(8))) short;
using s16x4  = __attribute__((ext_vector_type(4))) short;
using f32x16 = __attribute__((ext_vector_type(16))) float;
typedef __attribute__((ext_vector_type(2))) __bf16 bf2_t;
#define DI __device__ __forceinline__
#define MFMA32(a, b, c) __builtin_amdgcn_mfma_f32_32x32x16_bf16((a), (b), (c), 0, 0, 0)

constexpr int T_ = 32768, S_ = 16384;
constexpr float LOG2E = 1.4426950408889634f;
constexpr int LDS_BYTES = 73728;

constexpr long OFF_W0IN  = 0;
constexpr long OFF_W0OUT = OFF_W0IN  + 3200L * 1024 * 2;
constexpr long OFF_WGU0  = OFF_W0OUT + 1024L * 1024 * 2;
constexpr long OFF_WGU1  = OFF_WGU0  + 5632L * 1024 * 2;
constexpr long OFF_WDN0  = OFF_WGU1  + 5632L * 1024 * 2;
constexpr long OFF_WDN1  = OFF_WDN0  + 1024L * 2816 * 2;
constexpr long OFF_W1IN  = OFF_WDN1  + 1024L * 2816 * 2;
constexpr long OFF_W1OUT = OFF_W1IN  + 1536L * 1024 * 2;
constexpr long OFF_WUQ   = OFF_W1OUT + 1024L * 1024 * 2;
constexpr long OFF_WUKV  = OFF_WUQ   + 768L * 384 * 2;
constexpr long OFF_ROPE  = OFF_WUKV  + 1024L * 256 * 2;
constexpr long OFF_ML    = OFF_ROPE  + 16384L * 16 * 8;
constexpr long OFF_HBUF  = OFF_ML    + (long)T_ * 8 * 4 * 2;
constexpr long OFF_MIX   = OFF_HBUF  + (long)T_ * 1024 * 2;
constexpr long OFF_KV    = OFF_MIX   + (long)T_ * 1024 * 2;
constexpr long OFF_BIG   = OFF_KV    + (long)T_ * 1024 * 2;
constexpr long WS_NEED   = OFF_BIG   + (long)T_ * 3088 * 2;
constexpr long OFF_P1    = OFF_BIG;
constexpr long OFF_CQN   = OFF_P1   + (long)T_ * 1440 * 2;
constexpr long OFF_CKVN  = OFF_CQN  + (long)T_ * 384 * 2;
constexpr long OFF_KPE   = OFF_CKVN + (long)T_ * 256 * 2;
constexpr long OFF_Q     = OFF_KPE  + (long)T_ * 32 * 2;
constexpr long OUT_DST   = 0;
constexpr long OUT_SPT   = 2048L * 8192 * 4;
constexpr long OUT_DEC   = OUT_SPT + 2048L * 8192 * 2;

struct Params {
  const float *x, *n_mix_pre, *n_mix_post, *n_ffn_pre, *n_ffn_post, *ffn_g, *ffn_u, *ffn_d;
  const float *ab_in, *ab_out, *gla_wg, *gla_bg, *gla_norm, *cd_in, *cd_out, *sinks, *q_norm, *w_uq, *kv_norm, *w_ukv;
  float* out;
  char* ws;
};

DI unsigned pack2(float a, float b) { bf2_t v; v[0] = (__bf16)a; v[1] = (__bf16)b; return __builtin_bit_cast(unsigned, v); }
DI bf16_t f2bf(float a) { return __builtin_bit_cast(unsigned short, (__bf16)a); }
DI float bf2f(bf16_t v) { return __uint_as_float(((unsigned)v) << 16); }
DI float bflo(unsigned u) { return __uint_as_float(u << 16); }
DI float bfhi(unsigned u) { return __uint_as_float(u & 0xffff0000u); }
DI float ex2(float x) { return __builtin_amdgcn_exp2f(x); }
DI float rcpf(float x) { return __builtin_amdgcn_rcpf(x); }
DI float siluf(float x) { return x * rcpf(1.f + __expf(-x)); }
DI int crow(int reg, int hh) { return (reg & 3) + 8 * (reg >> 2) + 4 * hh; }
DI float wave_sum(float v) {
#pragma unroll
  for (int o = 32; o; o >>= 1) v += __shfl_xor(v, o);
  return v;
}
DI bf16x8 pack8(float a0, float a1, float a2, float a3, float a4, float a5, float a6, float a7) {
  uint4 u = make_uint4(pack2(a0, a1), pack2(a2, a3), pack2(a4, a5), pack2(a6, a7));
  return __builtin_bit_cast(bf16x8, u);
}
DI bf16x8 lds_frag(const bf16_t* base, int stride, int row0, int kofs, int l31, int hh) {
  return *(const bf16x8*)(base + (row0 + l31) * stride + kofs + hh * 8);
}
DI s16x4 tr_read(const bf16_t* p) {
  return __builtin_amdgcn_ds_read_tr16_b64_v4i16((__attribute__((address_space(3))) s16x4*)(p));
}

DI void phase_convert(const Params& p, char* smem) {
  float* tl = (float*)smem;
  const int tid = threadIdx.x;
  for (int it = blockIdx.x; it < 6056; it += gridDim.x) {
    const float *sa, *sb; int K, N, mode = 0, t; long doff;
    if (it < 800)       { t = it;        sa = p.ab_in;  sb = sa; K = 1024; N = 3088; doff = OFF_W0IN; }
    else if (it < 1056) { t = it - 800;  sa = p.ab_out; sb = sa; K = 1024; N = 1024; doff = OFF_W0OUT; }
    else if (it < 2464) { t = it - 1056; sa = p.ffn_g;  sb = p.ffn_u; K = 1024; N = 2816; mode = 1; doff = OFF_WGU0; }
    else if (it < 3872) { t = it - 2464; sa = p.ffn_g + 1024L * 2816; sb = p.ffn_u + 1024L * 2816; K = 1024; N = 2816; mode = 1; doff = OFF_WGU1; }
    else if (it < 4576) { t = it - 3872; sa = p.ffn_d;  sb = sa; K = 2816; N = 1024; doff = OFF_WDN0; }
    else if (it < 5280) { t = it - 4576; sa = p.ffn_d + 2816L * 1024; sb = sa; K = 2816; N = 1024; doff = OFF_WDN1; }
    else if (it < 5664) { t = it - 5280; sa = p.cd_in;  sb = sa; K = 1024; N = 1440; doff = OFF_W1IN; }
    else if (it < 5920) { t = it - 5664; sa = p.cd_out; sb = sa; K = 1024; N = 1024; doff = OFF_W1OUT; }
    else if (it < 5992) { t = it - 5920; sa = p.w_uq;   sb = sa; K = 384;  N = 768;  doff = OFF_WUQ; }
    else                { t = it - 5992; sa = p.w_ukv;  sb = sa; K = 256;  N = 1024; doff = OFF_WUKV; }
    bf16_t* dst = (bf16_t*)(p.ws + doff);
    const int nkt = K >> 6;
    const int kt = t % nkt, nt = t / nkt;
    const int k0 = kt * 64, n0 = nt * 64;
    const int nn = tid & 63, kr = tid >> 6;
    const float* src; int col;
    if (mode) { src = (nn < 32) ? sa : sb; col = nt * 32 + (nn & 31); }
    else      { src = sa; col = n0 + nn; }
    const bool ok = col < N;
#pragma unroll
    for (int i = 0; i < 16; i++) {
      const int kk = i * 4 + kr;
      tl[kk * 65 + nn] = ok ? src[(long)(k0 + kk) * N + col] : 0.f;
    }
    __syncthreads();
    const int n2 = tid >> 2, kq = (tid & 3) * 16;
    unsigned wv[8];
#pragma unroll
    for (int j = 0; j < 8; j++) wv[j] = pack2(tl[(kq + 2 * j) * 65 + n2], tl[(kq + 2 * j + 1) * 65 + n2]);
    uint4* dp = (uint4*)(dst + (long)(n0 + n2) * K + k0 + kq);
    dp[0] = make_uint4(wv[0], wv[1], wv[2], wv[3]);
    dp[1] = make_uint4(wv[4], wv[5], wv[6], wv[7]);
    __syncthreads();
  }
}

DI void phase_rope_table(const Params& p) {
  float2* tab = (float2*)(p.ws + OFF_ROPE);
  for (int i = blockIdx.x * 256 + threadIdx.x; i < 16384 * 16; i += gridDim.x * 256) {
    const int pos = i >> 4, j = i & 15;
    const float freq = exp2f(-(float)j * (13.287712379549449f / 16.f));
    const float ang = (float)pos * freq;
    const double a = (double)ang;
    const double k = rint(a * 0.15915494309189535);
    const float rf = (float)(a - k * 6.283185307179586);
    tab[i] = make_float2(__cosf(rf), __sinf(rf));
  }
}

DI void phase_rms_first(const float* __restrict__ x, const float* __restrict__ g, bf16_t* __restrict__ h) {
  const int lane = threadIdx.x & 63, w = threadIdx.x >> 6;
  for (int row = blockIdx.x * 4 + w; row < T_; row += gridDim.x * 4) {
    const float4* xr = (const float4*)(x + (long)row * 1024);
    float4 v[4]; float ss = 0.f;
#pragma unroll
    for (int i = 0; i < 4; i++) { v[i] = xr[lane + i * 64]; ss += v[i].x * v[i].x + v[i].y * v[i].y + v[i].z * v[i].z + v[i].w * v[i].w; }
    ss = wave_sum(ss);
    const float r = rsqrtf(ss * (1.f / 1024.f) + 1e-6f);
    uint2* hr = (uint2*)(h + (long)row * 1024);
#pragma unroll
    for (int i = 0; i < 4; i++) {
      const float4 gg = ((const float4*)g)[lane + i * 64];
      hr[lane + i * 64] = make_uint2(pack2(v[i].x * r * gg.x, v[i].y * r * gg.y), pack2(v[i].z * r * gg.z, v[i].w * r * gg.w));
    }
  }
}

DI void phase_resid(const float* xin, float* xout, bf16_t* yh, const float* __restrict__ gpost, const float* __restrict__ gnext) {
  const int lane = threadIdx.x & 63, w = threadIdx.x >> 6;
  for (int row = blockIdx.x * 4 + w; row < T_; row += gridDim.x * 4) {
    uint2* yr = (uint2*)(yh + (long)row * 1024);
    const float4* xr = (const float4*)(xin + (long)row * 1024);
    float4* xo = (float4*)(xout + (long)row * 1024);
    float4 y[4]; float ss = 0.f;
#pragma unroll
    for (int i = 0; i < 4; i++) {
      const uint2 u = yr[lane + i * 64];
      y[i] = make_float4(bflo(u.x), bfhi(u.x), bflo(u.y), bfhi(u.y));
      ss += y[i].x * y[i].x + y[i].y * y[i].y + y[i].z * y[i].z + y[i].w * y[i].w;
    }
    ss = wave_sum(ss);
    const float r1 = rsqrtf(ss * (1.f / 1024.f) + 1e-6f);
    float ss2 = 0.f;
#pragma unroll
    for (int i = 0; i < 4; i++) {
      const float4 gg = ((const float4*)gpost)[lane + i * 64];
      const float4 xv = xr[lane + i * 64];
      y[i].x = xv.x + y[i].x * r1 * gg.x; y[i].y = xv.y + y[i].y * r1 * gg.y;
      y[i].z = xv.z + y[i].z * r1 * gg.z; y[i].w = xv.w + y[i].w * r1 * gg.w;
      xo[lane + i * 64] = y[i];
      ss2 += y[i].x * y[i].x + y[i].y * y[i].y + y[i].z * y[i].z + y[i].w * y[i].w;
    }
    if (gnext) {
      ss2 = wave_sum(ss2);
      const float r2 = rsqrtf(ss2 * (1.f / 1024.f) + 1e-6f);
#pragma unroll
      for (int i = 0; i < 4; i++) {
        const float4 gg = ((const float4*)gnext)[lane + i * 64];
        yr[lane + i * 64] = make_uint2(pack2(y[i].x * r2 * gg.x, y[i].y * r2 * gg.y), pack2(y[i].z * r2 * gg.z, y[i].w * r2 * gg.w));
      }
    }
  }
}

constexpr int GLS = 72;
constexpr int GSTAGE = 2 * 128 * GLS;

template <class Epi>
DI void gemm_tile(const bf16_t* __restrict__ A, int lda, const bf16_t* __restrict__ Bt, int K, int m0, int n0, char* smem, const Epi& epi) {
  const int tid = threadIdx.x, lane = tid & 63, w = tid >> 6, l31 = lane & 31, hh = lane >> 5;
  const int wm = w >> 1, wn = w & 1;
  bf16_t* sb = (bf16_t*)smem;
  f32x16 acc[2][2];
#pragma unroll
  for (int a = 0; a < 2; a++)
#pragma unroll
    for (int b = 0; b < 2; b++)
#pragma unroll
      for (int r = 0; r < 16; r++) acc[a][b][r] = 0.f;
  const int nk = K >> 6;
  const int lr = tid >> 3, lk = (tid & 7) * 8;
  const bf16_t* ap = A + (long)(m0 + lr) * lda + lk;
  const bf16_t* bp = Bt + (long)(n0 + lr) * K + lk;
  uint4 ra[4], rb[4];
#pragma unroll
  for (int i = 0; i < 4; i++) { ra[i] = *(const uint4*)(ap + (long)i * 32 * lda); rb[i] = *(const uint4*)(bp + (long)i * 32 * K); }
#pragma unroll
  for (int i = 0; i < 4; i++) {
    *(uint4*)(sb + (lr + i * 32) * GLS + lk) = ra[i];
    *(uint4*)(sb + 128 * GLS + (lr + i * 32) * GLS + lk) = rb[i];
  }
  __syncthreads();
  for (int kt = 0; kt < nk; kt++) {
    const int cur = kt & 1;
    const bool more = (kt + 1) < nk;
    if (more) {
#pragma unroll
      for (int i = 0; i < 4; i++) {
        ra[i] = *(const uint4*)(ap + (long)i * 32 * lda + (kt + 1) * 64);
        rb[i] = *(const uint4*)(bp + (long)i * 32 * K + (kt + 1) * 64);
      }
    }
    const bf16_t* as = sb + cur * GSTAGE;
    const bf16_t* bs = as + 128 * GLS;
#pragma unroll
    for (int ks = 0; ks < 4; ks++) {
      const bf16x8 a0 = lds_frag(as, GLS, wm * 64, ks * 16, l31, hh);
      const bf16x8 a1 = lds_frag(as, GLS, wm * 64 + 32, ks * 16, l31, hh);
      const bf16x8 b0 = lds_frag(bs, GLS, wn * 64, ks * 16, l31, hh);
      const bf16x8 b1 = lds_frag(bs, GLS, wn * 64 + 32, ks * 16, l31, hh);
      acc[0][0] = MFMA32(a0, b0, acc[0][0]);
      acc[0][1] = MFMA32(a0, b1, acc[0][1]);
      acc[1][0] = MFMA32(a1, b0, acc[1][0]);
      acc[1][1] = MFMA32(a1, b1, acc[1][1]);
    }
    if (more) {
      bf16_t* an = sb + (cur ^ 1) * GSTAGE;
#pragma unroll
      for (int i = 0; i < 4; i++) {
        *(uint4*)(an + (lr + i * 32) * GLS + lk) = ra[i];
        *(uint4*)(an + 128 * GLS + (lr + i * 32) * GLS + lk) = rb[i];
      }
    }
    __syncthreads();
  }
  epi(acc, m0 + wm * 64, n0 + wn * 64, l31, hh);
}

struct EpiStore {
  bf16_t* C; int ldc; int nvalid;
  DI void operator()(f32x16 (&acc)[2][2], int r0, int c0, int l31, int hh) const {
#pragma unroll
    for (int mb = 0; mb < 2; mb++)
#pragma unroll
      for (int nb = 0; nb < 2; nb++) {
        const int col = c0 + nb * 32 + l31;
        if (col < nvalid) {
#pragma unroll
          for (int r = 0; r < 16; r++) C[(long)(r0 + mb * 32 + crow(r, hh)) * ldc + col] = f2bf(acc[mb][nb][r]);
        }
      }
  }
};
struct EpiSwiglu {
  bf16_t* C;
  DI void operator()(f32x16 (&acc)[2][2], int r0, int c0, int l31, int hh) const {
    const int col = (c0 >> 1) + l31;
#pragma unroll
    for (int mb = 0; mb < 2; mb++)
#pragma unroll
      for (int r = 0; r < 16; r++)
        C[(long)(r0 + mb * 32 + crow(r, hh)) * 2816 + col] = f2bf(siluf(acc[mb][0][r]) * acc[mb][1][r]);
  }
};
struct EpiQRope {
  bf16_t* C; const float2* tab;
  DI void operator()(f32x16 (&acc)[2][2], int r0, int c0, int l31, int hh) const {
#pragma unroll
    for (int nb = 0; nb < 2; nb++) {
      const int cb = (c0 >> 5) + nb;
      const bool rope = (cb % 3) == 2;
      const int col = c0 + nb * 32 + l31;
#pragma unroll
      for (int mb = 0; mb < 2; mb++)
#pragma unroll
        for (int r = 0; r < 16; r++) {
          const int row = r0 + mb * 32 + crow(r, hh);
          float v = acc[mb][nb][r];
          if (rope) {
            const float pv = __shfl_xor(v, 16);
            const float2 cs = tab[(row & (S_ - 1)) * 16 + (l31 & 15)];
            v = (l31 < 16) ? (v * cs.x - pv * cs.y) : (v * cs.x + pv * cs.y);
          }
          C[(long)row * 768 + col] = f2bf(v);
        }
    }
  }
};

template <class Epi>
DI void phase_gemm(const bf16_t* A, int lda, const bf16_t* Bt, int K, int ntiles_n, char* smem, const Epi& epi) {
  const int total = (T_ / 128) * ntiles_n;
  for (int t = blockIdx.x; t < total; t += gridDim.x) {
    const int mt = t / ntiles_n, nt = t % ntiles_n;
    gemm_tile(A, lda, Bt, K, mt * 128, nt * 128, smem, epi);
  }
}

template <int DQK>
DI void attn_tile(char* smem, const bf16_t* __restrict__ qp, int q_ld, const bf16_t* __restrict__ kp, int k_ld,
                  const bf16_t* __restrict__ k2p, int k2_ld, const bf16_t* __restrict__ vp, int v_ld,
                  long tok_base, int tok_stride, int q0, int kv_lo, int kv_hi, int win, float scale2, float slope2,
                  int mode, float sink2, float* st_o, float* st_ml, int st_h, bf16_t* outp, int out_ld) {
  constexpr int KS = DQK + 8, VS = 72, NKS = DQK / 16, CPR = DQK / 8;
  bf16_t* Ks = (bf16_t*)smem;
  bf16_t* Vs = Ks + 64 * KS;
  const int tid = threadIdx.x, lane = tid & 63, w = tid >> 6, l31 = lane & 31, hh = lane >> 5;
  const int qi = q0 + w * 32 + l31;
  const long qtok = tok_base + (long)qi * tok_stride;
  bf16x8 qf[NKS];
#pragma unroll
  for (int ks = 0; ks < NKS; ks++) qf[ks] = *(const bf16x8*)(qp + qtok * q_ld + ks * 16 + hh * 8);
  f32x16 o[2];
  float m = -1e30f, l = 0.f;
  if (mode == 2 || mode == 3) {
#pragma unroll
    for (int mb = 0; mb < 2; mb++)
#pragma unroll
      for (int g = 0; g < 4; g++) {
        const float4 v = *(const float4*)(st_o + qtok * 512 + st_h * 64 + mb * 32 + 8 * g + 4 * hh);
        o[mb][4 * g + 0] = v.x; o[mb][4 * g + 1] = v.y; o[mb][4 * g + 2] = v.z; o[mb][4 * g + 3] = v.w;
      }
    m = st_ml[qtok * 8 + st_h];
    l = st_ml[(long)T_ * 8 + qtok * 8 + st_h];
  } else {
#pragma unroll
    for (int mb = 0; mb < 2; mb++)
#pragma unroll
      for (int r = 0; r < 16; r++) o[mb][r] = 0.f;
  }
  const int q_lo = q0 + w * 32, q_hi = q_lo + 31;
  const int q4 = (lane & 15) >> 2, p4 = lane & 3, blk = (lane >> 4) & 1;

  for (int kv0 = kv_lo; kv0 < kv_hi; kv0 += 64) {
    __syncthreads();
    for (int c = tid; c < 64 * CPR; c += 256) {
      const int row = c / CPR, ch = c % CPR;
      const long tok = tok_base + (long)(kv0 + row) * tok_stride;
      uint4 v;
      if (DQK == 96 && ch >= 8) v = *(const uint4*)(k2p + tok * k2_ld + (ch - 8) * 8);
      else v = *(const uint4*)(kp + tok * k_ld + ch * 8);
      *(uint4*)(Ks + row * KS + ch * 8) = v;
    }
    for (int c = tid; c < 512; c += 256) {
      const int row = c >> 3, ch = c & 7;
      const long tok = tok_base + (long)(kv0 + row) * tok_stride;
      *(uint4*)(Vs + row * VS + ch * 8) = *(const uint4*)(vp + tok * v_ld + ch * 8);
    }
    __syncthreads();
    if (kv0 > q_hi || kv0 + 63 < q_lo - win) continue;

    f32x16 s[2];
#pragma unroll
    for (int kb = 0; kb < 2; kb++) {
#pragma unroll
      for (int r = 0; r < 16; r++) s[kb][r] = 0.f;
#pragma unroll
      for (int ks = 0; ks < NKS; ks++) {
        const bf16x8 a = lds_frag(Ks, KS, kb * 32, ks * 16, l31, hh);
        s[kb] = MFMA32(a, qf[ks], s[kb]);
      }
    }
    const bool full = (kv0 + 63 <= q_lo) && (kv0 >= q_hi - win) && (slope2 == 0.f);
    float mx = -INFINITY;
    if (full) {
#pragma unroll
      for (int kb = 0; kb < 2; kb++)
#pragma unroll
        for (int r = 0; r < 16; r++) { s[kb][r] *= scale2; mx = fmaxf(mx, s[kb][r]); }
    } else {
#pragma unroll
      for (int kb = 0; kb < 2; kb++)
#pragma unroll
        for (int r = 0; r < 16; r++) {
          const int rel = qi - (kv0 + kb * 32 + crow(r, hh));
          float v = s[kb][r] * scale2 - slope2 * (float)rel;
          v = (rel >= 0 && rel <= win) ? v : -INFINITY;
          s[kb][r] = v; mx = fmaxf(mx, v);
        }
    }
    mx = fmaxf(mx, __shfl_xor(mx, 32));
    const float mn = fmaxf(m, mx);
    const float alpha = ex2(m - mn);
    m = mn;
    float rs = 0.f;
#pragma unroll
    for (int kb = 0; kb < 2; kb++)
#pragma unroll
      for (int r = 0; r < 16; r++) { const float pv = ex2(s[kb][r] - mn); s[kb][r] = pv; rs += pv; }
    rs += __shfl_xor(rs, 32);
    l = l * alpha + rs;
#pragma unroll
    for (int mb = 0; mb < 2; mb++)
#pragma unroll
      for (int r = 0; r < 16; r++) o[mb][r] *= alpha;
#pragma unroll
    for (int kb = 0; kb < 2; kb++)
#pragma unroll
      for (int st = 0; st < 2; st++) {
        const bf16x8 pb = pack8(s[kb][8 * st + 0], s[kb][8 * st + 1], s[kb][8 * st + 2], s[kb][8 * st + 3],
                                s[kb][8 * st + 4], s[kb][8 * st + 5], s[kb][8 * st + 6], s[kb][8 * st + 7]);
#pragma unroll
        for (int mb = 0; mb < 2; mb++) {
          const bf16_t* base = Vs + (kb * 32 + 16 * st + 4 * hh + q4) * VS + mb * 32 + 16 * blk + 4 * p4;
          const s16x4 lo = tr_read(base);
          const s16x4 hi = tr_read(base + 8 * VS);
          const bf16x8 a = __builtin_shufflevector(lo, hi, 0, 1, 2, 3, 4, 5, 6, 7);
          o[mb] = MFMA32(a, pb, o[mb]);
        }
      }
  }
  if (mode == 1 || mode == 2) {
#pragma unroll
    for (int mb = 0; mb < 2; mb++)
#pragma unroll
      for (int g = 0; g < 4; g++)
        *(float4*)(st_o + qtok * 512 + st_h * 64 + mb * 32 + 8 * g + 4 * hh) =
            make_float4(o[mb][4 * g + 0], o[mb][4 * g + 1], o[mb][4 * g + 2], o[mb][4 * g + 3]);
    if (hh == 0) { st_ml[qtok * 8 + st_h] = m; st_ml[(long)T_ * 8 + qtok * 8 + st_h] = l; }
  } else {
    float mult;
    if (mode == 4) {
      const float mf = fmaxf(m, sink2);
      const float a = ex2(m - mf);
      mult = a * rcpf(l * a + ex2(sink2 - mf));
    } else {
      mult = rcpf(l);
    }
#pragma unroll
    for (int mb = 0; mb < 2; mb++)
#pragma unroll
      for (int g = 0; g < 4; g++)
        *(uint2*)(outp + qtok * out_ld + mb * 32 + 8 * g + 4 * hh) =
            make_uint2(pack2(o[mb][4 * g + 0] * mult, o[mb][4 * g + 1] * mult), pack2(o[mb][4 * g + 2] * mult, o[mb][4 * g + 3] * mult));
  }
}

DI void attnA_task(const Params& p, char* smem, int tau, int pat) {
  const int dil = (pat == 0) ? 1 : (pat == 1 ? 4 : 16);
  const int ntile = (S_ / dil) >> 7;
  const int bh = tau >> 7, rem = tau & 127;
  const int r = rem / ntile, n = rem % ntile;
  const int b = bh >> 3, h = bh & 7;
  const bf16_t* pj = (const bf16_t*)(p.ws + OFF_BIG);
  const int q0 = n * 128;
  const int kv_lo = (q0 >= 128) ? q0 - 128 : 0;
  const float slope2 = exp2f(-(float)(h + 1)) * (float)dil * LOG2E;
  const int mode = (pat == 0) ? 1 : (pat == 1 ? 2 : 3);
  attn_tile<64>(smem, pj + h * 64, 3088, pj + 512 + h * 64, 3088, nullptr, 0, pj + 1024 + h * 64, 3088,
                (long)b * S_ + r, dil, q0, kv_lo, q0 + 128, 128, 0.125f * LOG2E, slope2, mode, 0.f,
                (float*)(p.ws + OFF_HBUF), (float*)(p.ws + OFF_ML), h,
                (bf16_t*)(p.ws + OFF_MIX) + h * 64, 1024);
}

DI void attnC_task(const Params& p, char* smem, int tau) {
  const int b = tau >> 10, hq = (tau >> 7) & 7, tile = tau & 127;
  const int kvh = hq >> 2;
  const bf16_t* pj = (const bf16_t*)(p.ws + OFF_P1);
  const int q0 = tile * 128;
  const int kv_lo = (q0 >= 128) ? q0 - 128 : 0;
  attn_tile<64>(smem, pj + hq * 64, 1440, pj + 512 + kvh * 64, 1440, nullptr, 0, pj + 640 + kvh * 64, 1440,
                (long)b * S_, 1, q0, kv_lo, q0 + 128, 127, 0.125f * LOG2E, exp2f(-(float)(hq + 1)) * LOG2E, 4,
                p.sinks[hq] * LOG2E, nullptr, nullptr, 0, (bf16_t*)(p.ws + OFF_MIX) + hq * 64, 1024);
}

DI void attnD_task(const Params& p, char* smem, int tau) {
  const int bh = tau >> 6, i = tau & 63;
  const int b = bh >> 3, h = bh & 7;
  const bf16_t* qb = (const bf16_t*)(p.ws + OFF_Q);
  const bf16_t* kv = (const bf16_t*)(p.ws + OFF_KV);
  const bf16_t* kpe = (const bf16_t*)(p.ws + OFF_KPE);
  const float scale2 = 0.10206207261596575f * LOG2E;
#pragma unroll 1
  for (int u = 0; u < 2; u++) {
    const int tile = u ? i : (127 - i);
    const int q0 = tile * 128;
    attn_tile<96>(smem, qb + h * 96, 768, kv + h * 128, 1024, kpe, 32, kv + h * 128 + 64, 1024,
                  (long)b * S_, 1, q0, 0, q0 + 128, 1 << 30, scale2, 0.f, 0, 0.f, nullptr, nullptr, 0,
                  (bf16_t*)(p.ws + OFF_MIX) + 512 + h * 64, 1024);
  }
}

DI void gla_gate(const Params& p, float* bc, long tok0, int h, int tid) {
  const bf16_t* pj = (const bf16_t*)(p.ws + OFF_BIG);
  const int d = tid & 63, sg = tid >> 6;
  float wc[16];
#pragma unroll
  for (int r = 0; r < 16; r++) wc[r] = p.gla_wg[r * 256 + h * 64 + d];
  const float bias = p.gla_bg[h * 64 + d];
#pragma unroll 1
  for (int i = 0; i < 16; i++) {
    const int s = sg * 16 + i;
    const uint4* gp = (const uint4*)(pj + (tok0 + s) * 3088 + 3072);
    const uint4 g0 = gp[0], g1 = gp[1];
    float x = bias;
    x += bflo(g0.x) * wc[0] + bfhi(g0.x) * wc[1] + bflo(g0.y) * wc[2] + bfhi(g0.y) * wc[3];
    x += bflo(g0.z) * wc[4] + bfhi(g0.z) * wc[5] + bflo(g0.w) * wc[6] + bfhi(g0.w) * wc[7];
    x += bflo(g1.x) * wc[8] + bfhi(g1.x) * wc[9] + bflo(g1.y) * wc[10] + bfhi(g1.y) * wc[11];
    x += bflo(g1.z) * wc[12] + bfhi(g1.z) * wc[13] + bflo(g1.w) * wc[14] + bfhi(g1.w) * wc[15];
    const float ls = fminf(x, 0.f) - __logf(1.f + __expf(-fabsf(x)));
    bc[s * 64 + d] = ls * (1.f / 16.f);
  }
  __syncthreads();
  if (tid < 64) {
    float c = 0.f;
#pragma unroll 8
    for (int s = 0; s < 64; s++) { c += bc[s * 64 + tid]; bc[s * 64 + tid] = c; }
  }
  __syncthreads();
}

DI void gla_stage_vt(const Params& p, bf16_t* Vt, long tok0, int h, int tid) {
  const bf16_t* pj = (const bf16_t*)(p.ws + OFF_BIG);
  const int e = tid & 127, sg2 = tid >> 7;
  unsigned wv[16];
#pragma unroll
  for (int j = 0; j < 16; j++) {
    const unsigned lo = pj[(tok0 + sg2 * 32 + 2 * j) * 3088 + 2048 + h * 128 + e];
    const unsigned hi = pj[(tok0 + sg2 * 32 + 2 * j + 1) * 3088 + 2048 + h * 128 + e];
    wv[j] = lo | (hi << 16);
  }
  uint4* dp = (uint4*)(Vt + e * 72 + sg2 * 32);
  dp[0] = make_uint4(wv[0], wv[1], wv[2], wv[3]);
  dp[1] = make_uint4(wv[4], wv[5], wv[6], wv[7]);
  dp[2] = make_uint4(wv[8], wv[9], wv[10], wv[11]);
  dp[3] = make_uint4(wv[12], wv[13], wv[14], wv[15]);
}

DI void gla_a_task(const Params& p, char* smem, int task) {
  const int tid = threadIdx.x, lane = tid & 63, w = tid >> 6, l31 = lane & 31, hh = lane >> 5;
  const int bh = task >> 8, n = task & 255, b = bh >> 2, h = bh & 3;
  const long tok0 = (long)b * S_ + n * 64;
  float* bc = (float*)smem;
  bf16_t* Vt = (bf16_t*)(smem + 34816);
  bf16_t* KdT = (bf16_t*)(smem + 53248);
  const bf16_t* pj = (const bf16_t*)(p.ws + OFF_BIG);
  gla_gate(p, bc, tok0, h, tid);
  {
    const int d = tid & 63, sg = tid >> 6;
    const float bl = bc[63 * 64 + d];
    unsigned wv[8];
#pragma unroll
    for (int j = 0; j < 8; j++) {
      const int s0 = sg * 16 + 2 * j;
      const float k0 = bf2f(pj[(tok0 + s0) * 3088 + 1792 + h * 64 + d]) * __expf(bl - bc[s0 * 64 + d]);
      const float k1 = bf2f(pj[(tok0 + s0 + 1) * 3088 + 1792 + h * 64 + d]) * __expf(bl - bc[(s0 + 1) * 64 + d]);
      wv[j] = pack2(k0, k1);
    }
    uint4* dp = (uint4*)(KdT + d * 72 + sg * 16);
    dp[0] = make_uint4(wv[0], wv[1], wv[2], wv[3]);
    dp[1] = make_uint4(wv[4], wv[5], wv[6], wv[7]);
  }
  gla_stage_vt(p, Vt, tok0, h, tid);
  __syncthreads();
  f32x16 acc[2];
#pragma unroll
  for (int nb = 0; nb < 2; nb++)
#pragma unroll
    for (int r = 0; r < 16; r++) acc[nb][r] = 0.f;
#pragma unroll
  for (int ks = 0; ks < 4; ks++) {
    const bf16x8 a = lds_frag(Vt, 72, w * 32, ks * 16, l31, hh);
#pragma unroll
    for (int nb = 0; nb < 2; nb++) {
      const bf16x8 bb = lds_frag(KdT, 72, nb * 32, ks * 16, l31, hh);
      acc[nb] = MFMA32(a, bb, acc[nb]);
    }
  }
  float* dst = (float*)((char*)p.out + OUT_DST) + (long)task * 8192;
#pragma unroll
  for (int nb = 0; nb < 2; nb++)
#pragma unroll
    for (int r = 0; r < 16; r++) dst[(w * 32 + crow(r, hh)) * 64 + nb * 32 + l31] = acc[nb][r];
  if (tid < 64) ((float*)((char*)p.out + OUT_DEC))[task * 64 + tid] = __expf(bc[63 * 64 + tid]);
  __syncthreads();
}

DI void gla_scan_item(const Params& p, int item) {
  const int idx = item * 256 + threadIdx.x;
  const int bh = idx >> 13, ed = idx & 8191, d = ed & 63;
  const float* dS = (const float*)((char*)p.out + OUT_DST);
  const float* dec = (const float*)((char*)p.out + OUT_DEC);
  bf16_t* sp = (bf16_t*)((char*)p.out + OUT_SPT);
  float st = 0.f;
#pragma unroll 1
  for (int n = 0; n < 256; n += 8) {
    float ds[8], dc[8];
#pragma unroll
    for (int u = 0; u < 8; u++) {
      const long task = bh * 256 + n + u;
      ds[u] = dS[task * 8192 + ed];
      dc[u] = dec[task * 64 + d];
    }
#pragma unroll
    for (int u = 0; u < 8; u++) {
      const long task = bh * 256 + n + u;
      sp[task * 8192 + ed] = f2bf(st);
      st = dc[u] * st + ds[u];
    }
  }
}

DI void gla_c_task(const Params& p, char* smem, int task) {
  const int tid = threadIdx.x, lane = tid & 63, w = tid >> 6, l31 = lane & 31, hh = lane >> 5;
  const int bh = task >> 8, n = task & 255, b = bh >> 2, h = bh & 3;
  const long tok0 = (long)b * S_ + n * 64;
  float* bc = (float*)smem;
  bf16_t* att = (bf16_t*)smem;
  bf16_t* Qg = (bf16_t*)(smem + 16384);
  bf16_t* Kg = (bf16_t*)(smem + 25600);
  bf16_t* Vt = (bf16_t*)(smem + 34816);
  bf16_t* SpT = (bf16_t*)(smem + 53248);
  float* red = (float*)(smem + 71680);
  const bf16_t* pj = (const bf16_t*)(p.ws + OFF_BIG);
  gla_gate(p, bc, tok0, h, tid);
  {
    const int d = tid & 63, sg = tid >> 6;
    const float bm = bc[31 * 64 + d];
#pragma unroll 4
    for (int i = 0; i < 16; i++) {
      const int s = sg * 16 + i;
      const float bb = bc[s * 64 + d];
      const float qv = bf2f(pj[(tok0 + s) * 3088 + 1536 + h * 64 + d]);
      const float kv = bf2f(pj[(tok0 + s) * 3088 + 1792 + h * 64 + d]);
      Qg[s * 72 + d] = f2bf(qv * 0.125f * __expf(bb - bm));
      Kg[s * 72 + d] = f2bf(kv * __expf(bm - bb));
    }
  }
  gla_stage_vt(p, Vt, tok0, h, tid);
  {
    const int e = tid >> 1, hf = tid & 1;
    const uint4* sp = (const uint4*)((const bf16_t*)((char*)p.out + OUT_SPT) + (long)task * 8192 + e * 64 + hf * 32);
    uint4* dp = (uint4*)(SpT + e * 72 + hf * 32);
#pragma unroll
    for (int c = 0; c < 4; c++) {
      const uint4 v = sp[c];
      const int d0 = hf * 32 + c * 8;
      uint4 o;
      o.x = pack2(bflo(v.x) * __expf(bc[31 * 64 + d0 + 0]), bfhi(v.x) * __expf(bc[31 * 64 + d0 + 1]));
      o.y = pack2(bflo(v.y) * __expf(bc[31 * 64 + d0 + 2]), bfhi(v.y) * __expf(bc[31 * 64 + d0 + 3]));
      o.z = pack2(bflo(v.z) * __expf(bc[31 * 64 + d0 + 4]), bfhi(v.z) * __expf(bc[31 * 64 + d0 + 5]));
      o.w = pack2(bflo(v.w) * __expf(bc[31 * 64 + d0 + 6]), bfhi(v.w) * __expf(bc[31 * 64 + d0 + 7]));
      dp[c] = o;
    }
  }
  __syncthreads();
  {
    const int mb = w & 1, nb = w >> 1;
    f32x16 a2;
#pragma unroll
    for (int r = 0; r < 16; r++) a2[r] = 0.f;
#pragma unroll
    for (int ks = 0; ks < 4; ks++) {
      const bf16x8 a = lds_frag(Qg, 72, mb * 32, ks * 16, l31, hh);
      const bf16x8 bb = lds_frag(Kg, 72, nb * 32, ks * 16, l31, hh);
      a2 = MFMA32(a, bb, a2);
    }
#pragma unroll
    for (int r = 0; r < 16; r++) {
      const int c = mb * 32 + crow(r, hh), s = nb * 32 + l31;
      att[c * 72 + s] = f2bf((s <= c) ? a2[r] : 0.f);
    }
  }
  __syncthreads();
  f32x16 acc[2];
#pragma unroll
  for (int nb = 0; nb < 2; nb++)
#pragma unroll
    for (int r = 0; r < 16; r++) acc[nb][r] = 0.f;
#pragma unroll
  for (int ks = 0; ks < 4; ks++) {
    const bf16x8 a = lds_frag(Vt, 72, w * 32, ks * 16, l31, hh);
#pragma unroll
    for (int nb = 0; nb < 2; nb++) acc[nb] = MFMA32(a, lds_frag(att, 72, nb * 32, ks * 16, l31, hh), acc[nb]);
  }
#pragma unroll
  for (int ks = 0; ks < 4; ks++) {
    const bf16x8 a = lds_frag(SpT, 72, w * 32, ks * 16, l31, hh);
#pragma unroll
    for (int nb = 0; nb < 2; nb++) acc[nb] = MFMA32(a, lds_frag(Qg, 72, nb * 32, ks * 16, l31, hh), acc[nb]);
  }
#pragma unroll
  for (int nb = 0; nb < 2; nb++) {
    float ss = 0.f;
#pragma unroll
    for (int r = 0; r < 16; r++) ss += acc[nb][r] * acc[nb][r];
    ss += __shfl_xor(ss, 32);
    if (hh == 0) red[w * 64 + nb * 32 + l31] = ss;
  }
  __syncthreads();
  bf16_t* mix = (bf16_t*)(p.ws + OFF_MIX);
#pragma unroll
  for (int nb = 0; nb < 2; nb++) {
    const int c = nb * 32 + l31;
    const float tot = red[c] + red[64 + c] + red[128 + c] + red[192 + c];
    const float rn = rsqrtf(tot * (1.f / 128.f) + 1e-6f);
    const long tok = tok0 + c;
#pragma unroll
    for (int g = 0; g < 4; g++) {
      const int e0 = w * 32 + 8 * g + 4 * hh;
      const float4 gn = *(const float4*)(p.gla_norm + e0);
      const uint2 rr = *(const uint2*)(pj + tok * 3088 + 2560 + h * 128 + e0);
      const float o0 = acc[nb][4 * g + 0] * rn * gn.x * siluf(bflo(rr.x));
      const float o1 = acc[nb][4 * g + 1] * rn * gn.y * siluf(bfhi(rr.x));
      const float o2 = acc[nb][4 * g + 2] * rn * gn.z * siluf(bflo(rr.y));
      const float o3 = acc[nb][4 * g + 3] * rn * gn.w * siluf(bfhi(rr.y));
      *(uint2*)(mix + tok * 1024 + 512 + h * 128 + e0) = make_uint2(pack2(o0, o1), pack2(o2, o3));
    }
  }
  __syncthreads();
}

DI void phase_latent(const Params& p) {
  const int lane = threadIdx.x & 63, w = threadIdx.x >> 6;
  const bf16_t* pj = (const bf16_t*)(p.ws + OFF_P1);
  bf16_t* cqn = (bf16_t*)(p.ws + OFF_CQN);
  bf16_t* ckvn = (bf16_t*)(p.ws + OFF_CKVN);
  bf16_t* kpe = (bf16_t*)(p.ws + OFF_KPE);
  const float2* tab = (const float2*)(p.ws + OFF_ROPE);
  for (int row = blockIdx.x * 4 + w; row < T_; row += gridDim.x * 4) {
    const bf16_t* pr = pj + (long)row * 1440;
    uint4 a = make_uint4(0, 0, 0, 0), c = make_uint4(0, 0, 0, 0);
    if (lane < 48) a = *(const uint4*)(pr + 768 + lane * 8);
    if (lane < 32) c = *(const uint4*)(pr + 1152 + lane * 8);
    float av[8] = {bflo(a.x), bfhi(a.x), bflo(a.y), bfhi(a.y), bflo(a.z), bfhi(a.z), bflo(a.w), bfhi(a.w)};
    float cv[8] = {bflo(c.x), bfhi(c.x), bflo(c.y), bfhi(c.y), bflo(c.z), bfhi(c.z), bflo(c.w), bfhi(c.w)};
    float sa = 0.f, sc = 0.f;
#pragma unroll
    for (int j = 0; j < 8; j++) { sa += av[j] * av[j]; sc += cv[j] * cv[j]; }
    sa = wave_sum(sa); sc = wave_sum(sc);
    const float ra = rsqrtf(sa * (1.f / 384.f) + 1e-6f), rc = rsqrtf(sc * (1.f / 256.f) + 1e-6f);
    if (lane < 48) {
      const float4 g0 = *(const float4*)(p.q_norm + lane * 8), g1 = *(const float4*)(p.q_norm + lane * 8 + 4);
      *(uint4*)(cqn + (long)row * 384 + lane * 8) =
          make_uint4(pack2(av[0] * ra * g0.x, av[1] * ra * g0.y), pack2(av[2] * ra * g0.z, av[3] * ra * g0.w),
                     pack2(av[4] * ra * g1.x, av[5] * ra * g1.y), pack2(av[6] * ra * g1.z, av[7] * ra * g1.w));
    }
    if (lane < 32) {
      const float4 g0 = *(const float4*)(p.kv_norm + lane * 8), g1 = *(const float4*)(p.kv_norm + lane * 8 + 4);
      *(uint4*)(ckvn + (long)row * 256 + lane * 8) =
          make_uint4(pack2(cv[0] * rc * g0.x, cv[1] * rc * g0.y), pack2(cv[2] * rc * g0.z, cv[3] * rc * g0.w),
                     pack2(cv[4] * rc * g1.x, cv[5] * rc * g1.y), pack2(cv[6] * rc * g1.z, cv[7] * rc * g1.w));
    }
    if (lane < 16) {
      const float t1 = bf2f(pr[1408 + lane]), t2 = bf2f(pr[1408 + 16 + lane]);
      const float2 cs = tab[(row & (S_ - 1)) * 16 + lane];
      kpe[(long)row * 32 + lane] = f2bf(t1 * cs.x - t2 * cs.y);
      kpe[(long)row * 32 + 16 + lane] = f2bf(t2 * cs.x + t1 * cs.y);
    }
  }
}

__global__ void __launch_bounds__(256, 2) mega_kernel(Params p) {
  __shared__ __attribute__((aligned(16))) char smem[LDS_BYTES];
  cg::grid_group grid = cg::this_grid();
  char* ws = p.ws;
  bf16_t* hbuf = (bf16_t*)(ws + OFF_HBUF);
  bf16_t* mix = (bf16_t*)(ws + OFF_MIX);
  bf16_t* big = (bf16_t*)(ws + OFF_BIG);
  const int G = gridDim.x, bid = blockIdx.x;

  phase_convert(p, smem);
  phase_rope_table(p);
  phase_rms_first(p.x, p.n_mix_pre, hbuf);
  grid.sync();
  phase_gemm(hbuf, 1024, (const bf16_t*)(ws + OFF_W0IN), 1024, 25, smem, EpiStore{big, 3088, 3088});
  grid.sync();
  for (int t = bid; t < 4096; t += G) { if (t < 2048) gla_a_task(p, smem, t); else attnA_task(p, smem, t - 2048, 0); }
  grid.sync();
  for (int t = bid; t < 256 + 2048; t += G) { if (t < 256) gla_scan_item(p, t); else attnA_task(p, smem, t - 256, 1); }
  grid.sync();
  for (int t = bid; t < 4096; t += G) { if (t < 2048) gla_c_task(p, smem, t); else attnA_task(p, smem, t - 2048, 2); }
  grid.sync();
  phase_gemm(mix, 1024, (const bf16_t*)(ws + OFF_W0OUT), 1024, 8, smem, EpiStore{hbuf, 1024, 1024});
  grid.sync();
  phase_resid(p.x, p.out, hbuf, p.n_mix_post, p.n_ffn_pre);
  grid.sync();
  phase_gemm(hbuf, 1024, (const bf16_t*)(ws + OFF_WGU0), 1024, 44, smem, EpiSwiglu{big});
  grid.sync();
  phase_gemm(big, 2816, (const bf16_t*)(ws + OFF_WDN0), 2816, 8, smem, EpiStore{hbuf, 1024, 1024});
  grid.sync();
  phase_resid(p.out, p.out, hbuf, p.n_ffn_post, p.n_mix_pre + 1024);
  grid.sync();
  phase_gemm(hbuf, 1024, (const bf16_t*)(ws + OFF_W1IN), 1024, 12, smem, EpiStore{(bf16_t*)(ws + OFF_P1), 1440, 1440});
  grid.sync();
  phase_latent(p);
  grid.sync();
  {
    const EpiQRope eq{(bf16_t*)(ws + OFF_Q), (const float2*)(ws + OFF_ROPE)};
    const EpiStore ekv{(bf16_t*)(ws + OFF_KV), 1024, 1024};
    for (int t = bid; t < 256 * 6 + 256 * 8; t += G) {
      if (t < 1536) gemm_tile((const bf16_t*)(ws + OFF_CQN), 384, (const bf16_t*)(ws + OFF_WUQ), 384, (t / 6) * 128, (t % 6) * 128, smem, eq);
      else { const int u = t - 1536; gemm_tile((const bf16_t*)(ws + OFF_CKVN), 256, (const bf16_t*)(ws + OFF_WUKV), 256, (u >> 3) * 128, (u & 7) * 128, smem, ekv); }
    }
  }
  grid.sync();
  for (int t = bid; t < 1024 + 2048; t += G) { if (t < 1024) attnD_task(p, smem, t); else attnC_task(p, smem, t - 1024); }
  grid.sync();
  phase_gemm(mix, 1024, (const bf16_t*)(ws + OFF_W1OUT), 1024, 8, smem, EpiStore{hbuf, 1024, 1024});
  grid.sync();
  phase_resid(p.out, p.out, hbuf, p.n_mix_post + 1024, p.n_ffn_pre + 1024);
  grid.sync();
  phase_gemm(hbuf, 1024, (const bf16_t*)(ws + OFF_WGU1), 1024, 44, smem, EpiSwiglu{big});
  grid.sync();
  phase_gemm(big, 2816, (const bf16_t*)(ws + OFF_WDN1), 2816, 8, smem, EpiStore{hbuf, 1024, 1024});
  grid.sync();
  phase_resid(p.out, p.out, hbuf, p.n_ffn_post + 1024, nullptr);
}

extern "C" void kernel_launch(void* const* d_in, const int* in_sizes, int n_in, void* d_out, int out_size, void* d_ws,
                              size_t ws_size, hipStream_t stream) {
  static int grid_blocks = 0;
  if (!grid_blocks) {
    int dev = 0, cus = 0, per_cu = 0;
    hipGetDevice(&dev);
    hipDeviceGetAttribute(&cus, hipDeviceAttributeMultiprocessorCount, dev);
    hipOccupancyMaxActiveBlocksPerMultiprocessor(&per_cu, mega_kernel, 256, 0);
    if (per_cu < 1) per_cu = 1;
    grid_blocks = cus * per_cu;
  }
  if (ws_size < (size_t)WS_NEED) { fprintf(stderr, "workspace too small: %zu < %ld\n", ws_size, (long)WS_NEED); return; }
  Params p{};
  const float** f = (const float**)&p;
  for (int i = 0; i < 20; i++) f[i] = (const float*)d_in[i];
  p.out = (float*)d_out;
  p.ws = (char*)d_ws;
  void* args[] = {&p};
  hipError_t e = hipLaunchCooperativeKernel((void*)mega_kernel, dim3(grid_blocks), dim3(256), args, 0, stream);
  if (e != hipSuccess) fprintf(stderr, "cooperative launch failed: %s (grid %d)\n", hipGetErrorString(e), grid_blocks);
}
```

```cpp
#include <hip/hip_runtime.h>
#include <hip/hip_cooperative_groups.h>
#include <cstdio>
namespace cg = cooperative_groups;

typedef unsigned short bf16_t;
using bf16x8 = __attribute__((ext_vector_type(8))) short;
using s16x4  = __attribute__((ext_vector_type(4))) short;
using f32x16 = __attribute__((ext_vector_type(16))) float;
typedef __attribute__((ext_vector_type(2))) __bf16 bf2_t;
#define DI __device__ __forceinline__
#define MFMA32(a, b, c) __builtin_amdgcn_mfma_f32_32x32x16_bf16((a), (b), (c), 0, 0, 0)

constexpr int T_ = 32768, S_ = 16384;
constexpr float LOG2E = 1.4426950408889634f;
constexpr int LDS_BYTES = 147456;
constexpr int NTHR = 512;

constexpr long OFF_W0IN  = 0;
constexpr long OFF_W0OUT = OFF_W0IN  + 3328L * 1024 * 2;
constexpr long OFF_WGU0  = OFF_W0OUT + 1024L * 1024 * 2;
constexpr long OFF_WGU1  = OFF_WGU0  + 5632L * 1024 * 2;
constexpr long OFF_WDN0  = OFF_WGU1  + 5632L * 1024 * 2;
constexpr long OFF_WDN1  = OFF_WDN0  + 1024L * 2816 * 2;
constexpr long OFF_W1IN  = OFF_WDN1  + 1024L * 2816 * 2;
constexpr long OFF_W1OUT = OFF_W1IN  + 1536L * 1024 * 2;
constexpr long OFF_WUQ   = OFF_W1OUT + 1024L * 1024 * 2;
constexpr long OFF_WUKV  = OFF_WUQ   + 768L * 384 * 2;
constexpr long OFF_ROPE  = OFF_WUKV  + 1024L * 256 * 2;
constexpr long OFF_ML    = OFF_ROPE  + 16384L * 16 * 8;
constexpr long OFF_HBUF  = OFF_ML    + (long)T_ * 8 * 4 * 2;
constexpr long OFF_MIX   = OFF_HBUF  + (long)T_ * 1024 * 2;
constexpr long OFF_KV    = OFF_MIX   + (long)T_ * 1024 * 2;
constexpr long OFF_BIG   = OFF_KV    + (long)T_ * 1024 * 2;
constexpr long WS_NEED   = OFF_BIG   + (long)T_ * 3088 * 2;
constexpr long OFF_P1    = OFF_BIG;
constexpr long OFF_CQN   = OFF_P1   + (long)T_ * 1440 * 2;
constexpr long OFF_CKVN  = OFF_CQN  + (long)T_ * 384 * 2;
constexpr long OFF_KPE   = OFF_CKVN + (long)T_ * 256 * 2;
constexpr long OFF_Q     = OFF_KPE  + (long)T_ * 32 * 2;
constexpr long OUT_DST   = 0;
constexpr long OUT_SPT   = 2048L * 8192 * 4;
constexpr long OUT_DEC   = OUT_SPT + 2048L * 8192 * 2;

struct Params {
  const float *x, *n_mix_pre, *n_mix_post, *n_ffn_pre, *n_ffn_post, *ffn_g, *ffn_u, *ffn_d;
  const float *ab_in, *ab_out, *gla_wg, *gla_bg, *gla_norm, *cd_in, *cd_out, *sinks, *q_norm, *w_uq, *kv_norm, *w_ukv;
  float* out;
  char* ws;
};

DI unsigned pack2(float a, float b) { bf2_t v; v[0] = (__bf16)a; v[1] = (__bf16)b; return __builtin_bit_cast(unsigned, v); }
DI bf16_t f2bf(float a) { return __builtin_bit_cast(unsigned short, (__bf16)a); }
DI float bf2f(bf16_t v) { return __uint_as_float(((unsigned)v) << 16); }
DI float bflo(unsigned u) { return __uint_as_float(u << 16); }
DI float bfhi(unsigned u) { return __uint_as_float(u & 0xffff0000u); }
DI float ex2(float x) { return __builtin_amdgcn_exp2f(x); }
DI float rcpf(float x) { return __builtin_amdgcn_rcpf(x); }
DI float siluf(float x) { return x * rcpf(1.f + __expf(-x)); }
DI int crow(int reg, int hh) { return (reg & 3) + 8 * (reg >> 2) + 4 * hh; }
DI float wave_sum(float v) {
#pragma unroll
  for (int o = 32; o; o >>= 1) v += __shfl_xor(v, o);
  return v;
}
DI bf16x8 pack8(float a0, float a1, float a2, float a3, float a4, float a5, float a6, float a7) {
  uint4 u = make_uint4(pack2(a0, a1), pack2(a2, a3), pack2(a4, a5), pack2(a6, a7));
  return __builtin_bit_cast(bf16x8, u);
}
DI bf16x8 lds_frag(const bf16_t* base, int stride, int row0, int kofs, int l31, int hh) {
  return *(const bf16x8*)(base + (row0 + l31) * stride + kofs + hh * 8);
}
DI s16x4 tr_read(const bf16_t* p) {
  return __builtin_amdgcn_ds_read_tr16_b64_v4i16((__attribute__((address_space(3))) s16x4*)(p));
}

DI void phase_convert(const Params& p, char* smem) {
  const int tid = threadIdx.x & 255, grp = threadIdx.x >> 8;
  float* tl = (float*)(smem + grp * 16640);
  for (int it0 = blockIdx.x * 2; it0 < 6088; it0 += gridDim.x * 2) {
    const int it = it0 + grp;
    const float *sa, *sb; int K, N, mode = 0, t; long doff;
    if (it < 832)       { t = it;        sa = p.ab_in;  sb = sa; K = 1024; N = 3088; doff = OFF_W0IN; }
    else if (it < 1088) { t = it - 832;  sa = p.ab_out; sb = sa; K = 1024; N = 1024; doff = OFF_W0OUT; }
    else if (it < 2496) { t = it - 1088; sa = p.ffn_g;  sb = p.ffn_u; K = 1024; N = 2816; mode = 1; doff = OFF_WGU0; }
    else if (it < 3904) { t = it - 2496; sa = p.ffn_g + 1024L * 2816; sb = p.ffn_u + 1024L * 2816; K = 1024; N = 2816; mode = 1; doff = OFF_WGU1; }
    else if (it < 4608) { t = it - 3904; sa = p.ffn_d;  sb = sa; K = 2816; N = 1024; doff = OFF_WDN0; }
    else if (it < 5312) { t = it - 4608; sa = p.ffn_d + 2816L * 1024; sb = sa; K = 2816; N = 1024; doff = OFF_WDN1; }
    else if (it < 5696) { t = it - 5312; sa = p.cd_in;  sb = sa; K = 1024; N = 1440; doff = OFF_W1IN; }
    else if (it < 5952) { t = it - 5696; sa = p.cd_out; sb = sa; K = 1024; N = 1024; doff = OFF_W1OUT; }
    else if (it < 6024) { t = it - 5952; sa = p.w_uq;   sb = sa; K = 384;  N = 768;  doff = OFF_WUQ; }
    else                { t = it - 6024; sa = p.w_ukv;  sb = sa; K = 256;  N = 1024; doff = OFF_WUKV; }
    bf16_t* dst = (bf16_t*)(p.ws + doff);
    const int nkt = K >> 6;
    const int kt = t % nkt, nt = t / nkt;
    const int k0 = kt * 64, n0 = nt * 64;
    const int nn = tid & 63, kr = tid >> 6;
    const float* src; int col;
    if (mode) { src = (nn < 32) ? sa : sb; col = nt * 32 + (nn & 31); }
    else      { src = sa; col = n0 + nn; }
    const bool ok = col < N;
#pragma unroll
    for (int i = 0; i < 16; i++) {
      const int kk = i * 4 + kr;
      tl[kk * 65 + nn] = ok ? src[(long)(k0 + kk) * N + col] : 0.f;
    }
    __syncthreads();
    const int n2 = tid >> 2, kq = (tid & 3) * 16;
    unsigned wv[8];
#pragma unroll
    for (int j = 0; j < 8; j++) wv[j] = pack2(tl[(kq + 2 * j) * 65 + n2], tl[(kq + 2 * j + 1) * 65 + n2]);
    uint4* dp = (uint4*)(dst + (long)(n0 + n2) * K + k0 + kq);
    dp[0] = make_uint4(wv[0], wv[1], wv[2], wv[3]);
    dp[1] = make_uint4(wv[4], wv[5], wv[6], wv[7]);
    __syncthreads();
  }
}

DI void phase_rope_table(const Params& p) {
  float2* tab = (float2*)(p.ws + OFF_ROPE);
  for (int i = blockIdx.x * NTHR + threadIdx.x; i < 16384 * 16; i += gridDim.x * NTHR) {
    const int pos = i >> 4, j = i & 15;
    const float freq = exp2f(-(float)j * (13.287712379549449f / 16.f));
    const float ang = (float)pos * freq;
    const double a = (double)ang;
    const double k = rint(a * 0.15915494309189535);
    const float rf = (float)(a - k * 6.283185307179586);
    tab[i] = make_float2(__cosf(rf), __sinf(rf));
  }
}

DI void phase_rms_first(const float* __restrict__ x, const float* __restrict__ g, bf16_t* __restrict__ h) {
  const int lane = threadIdx.x & 63, w = threadIdx.x >> 6;
  for (int row = blockIdx.x * 8 + w; row < T_; row += gridDim.x * 8) {
    const float4* xr = (const float4*)(x + (long)row * 1024);
    float4 v[4]; float ss = 0.f;
#pragma unroll
    for (int i = 0; i < 4; i++) { v[i] = xr[lane + i * 64]; ss += v[i].x * v[i].x + v[i].y * v[i].y + v[i].z * v[i].z + v[i].w * v[i].w; }
    ss = wave_sum(ss);
    const float r = rsqrtf(ss * (1.f / 1024.f) + 1e-6f);
    uint2* hr = (uint2*)(h + (long)row * 1024);
#pragma unroll
    for (int i = 0; i < 4; i++) {
      const float4 gg = ((const float4*)g)[lane + i * 64];
      hr[lane + i * 64] = make_uint2(pack2(v[i].x * r * gg.x, v[i].y * r * gg.y), pack2(v[i].z * r * gg.z, v[i].w * r * gg.w));
    }
  }
}

DI void phase_resid(const float* xin, float* xout, bf16_t* yh, const float* __restrict__ gpost, const float* __restrict__ gnext) {
  const int lane = threadIdx.x & 63, w = threadIdx.x >> 6;
  for (int row = blockIdx.x * 8 + w; row < T_; row += gridDim.x * 8) {
    uint2* yr = (uint2*)(yh + (long)row * 1024);
    const float4* xr = (const float4*)(xin + (long)row * 1024);
    float4* xo = (float4*)(xout + (long)row * 1024);
    float4 y[4]; float ss = 0.f;
#pragma unroll
    for (int i = 0; i < 4; i++) {
      const uint2 u = yr[lane + i * 64];
      y[i] = make_float4(bflo(u.x), bfhi(u.x), bflo(u.y), bfhi(u.y));
      ss += y[i].x * y[i].x + y[i].y * y[i].y + y[i].z * y[i].z + y[i].w * y[i].w;
    }
    ss = wave_sum(ss);
    const float r1 = rsqrtf(ss * (1.f / 1024.f) + 1e-6f);
    float ss2 = 0.f;
#pragma unroll
    for (int i = 0; i < 4; i++) {
      const float4 gg = ((const float4*)gpost)[lane + i * 64];
      const float4 xv = xr[lane + i * 64];
      y[i].x = xv.x + y[i].x * r1 * gg.x; y[i].y = xv.y + y[i].y * r1 * gg.y;
      y[i].z = xv.z + y[i].z * r1 * gg.z; y[i].w = xv.w + y[i].w * r1 * gg.w;
      xo[lane + i * 64] = y[i];
      ss2 += y[i].x * y[i].x + y[i].y * y[i].y + y[i].z * y[i].z + y[i].w * y[i].w;
    }
    if (gnext) {
      ss2 = wave_sum(ss2);
      const float r2 = rsqrtf(ss2 * (1.f / 1024.f) + 1e-6f);
#pragma unroll
      for (int i = 0; i < 4; i++) {
        const float4 gg = ((const float4*)gnext)[lane + i * 64];
        yr[lane + i * 64] = make_uint2(pack2(y[i].x * r2 * gg.x, y[i].y * r2 * gg.y), pack2(y[i].z * r2 * gg.z, y[i].w * r2 * gg.w));
      }
    }
  }
}

constexpr int GLS = 72;
constexpr int GSTAGE = 512 * GLS;
constexpr int CLS = 260;

template <int OUTW>
DI void copy_tile(const bf16_t* cs, bf16_t* C, int ldc, int m0, int c0, int nvalid) {
  constexpr int CPRW = OUTW / 4;
  for (int c = threadIdx.x; c < 256 * CPRW; c += NTHR) {
    const int row = c / CPRW, ch = c % CPRW;
    const int col = c0 + ch * 4;
    if (col < nvalid) *(uint2*)(C + (long)(m0 + row) * ldc + col) = *(const uint2*)(cs + row * CLS + ch * 4);
  }
}

template <class Epi>
DI void gemm_tile(const bf16_t* __restrict__ A, int lda, const bf16_t* __restrict__ Bt, int K, int m0, int n0, char* smem, const Epi& epi) {
  const int tid = threadIdx.x, lane = tid & 63, w = tid >> 6, l31 = lane & 31, hh = lane >> 5;
  const int wm = w >> 2, wn = w & 3;
  bf16_t* sb = (bf16_t*)smem;
  f32x16 acc[4][2];
#pragma unroll
  for (int a = 0; a < 4; a++)
#pragma unroll
    for (int b = 0; b < 2; b++)
#pragma unroll
      for (int r = 0; r < 16; r++) acc[a][b][r] = 0.f;
  const int nk = K >> 6;
  const int lr = tid >> 3, lk = (tid & 7) * 8;
  const bf16_t* ap = A + (long)(m0 + lr) * lda + lk;
  const bf16_t* bp = Bt + (long)(n0 + lr) * K + lk;
  uint4 ra[4], rb[4];
#pragma unroll
  for (int i = 0; i < 4; i++) { ra[i] = *(const uint4*)(ap + (long)i * 64 * lda); rb[i] = *(const uint4*)(bp + (long)i * 64 * K); }
#pragma unroll
  for (int i = 0; i < 4; i++) {
    *(uint4*)(sb + (lr + i * 64) * GLS + lk) = ra[i];
    *(uint4*)(sb + 256 * GLS + (lr + i * 64) * GLS + lk) = rb[i];
  }
  __syncthreads();
  for (int kt = 0; kt < nk; kt++) {
    const int cur = kt & 1;
    const bool more = (kt + 1) < nk;
    if (more) {
#pragma unroll
      for (int i = 0; i < 4; i++) {
        ra[i] = *(const uint4*)(ap + (long)i * 64 * lda + (kt + 1) * 64);
        rb[i] = *(const uint4*)(bp + (long)i * 64 * K + (kt + 1) * 64);
      }
    }
    const bf16_t* as = sb + cur * GSTAGE;
    const bf16_t* bs = as + 256 * GLS;
#pragma unroll
    for (int ks = 0; ks < 4; ks++) {
      const bf16x8 b0 = lds_frag(bs, GLS, wn * 64, ks * 16, l31, hh);
      const bf16x8 b1 = lds_frag(bs, GLS, wn * 64 + 32, ks * 16, l31, hh);
#pragma unroll
      for (int mb = 0; mb < 4; mb++) {
        const bf16x8 a = lds_frag(as, GLS, wm * 128 + mb * 32, ks * 16, l31, hh);
        acc[mb][0] = MFMA32(b0, a, acc[mb][0]);
        acc[mb][1] = MFMA32(b1, a, acc[mb][1]);
      }
    }
    if (more) {
      bf16_t* an = sb + (cur ^ 1) * GSTAGE;
#pragma unroll
      for (int i = 0; i < 4; i++) {
        *(uint4*)(an + (lr + i * 64) * GLS + lk) = ra[i];
        *(uint4*)(an + 256 * GLS + (lr + i * 64) * GLS + lk) = rb[i];
      }
    }
    __syncthreads();
  }
  epi.stage(acc, sb, wm * 128, wn * 64, m0, n0, l31, hh);
  __syncthreads();
  epi.copy(sb, m0, n0);
  __syncthreads();
}

struct EpiStore {
  bf16_t* C; int ldc; int nvalid;
  DI void stage(f32x16 (&acc)[4][2], bf16_t* cs, int wr0, int wc0, int m0, int n0, int l31, int hh) const {
#pragma unroll
    for (int mb = 0; mb < 4; mb++)
#pragma unroll
      for (int nb = 0; nb < 2; nb++)
#pragma unroll
        for (int g = 0; g < 4; g++)
          *(uint2*)(cs + (wr0 + mb * 32 + l31) * CLS + wc0 + nb * 32 + 8 * g + 4 * hh) =
              make_uint2(pack2(acc[mb][nb][4 * g], acc[mb][nb][4 * g + 1]), pack2(acc[mb][nb][4 * g + 2], acc[mb][nb][4 * g + 3]));
  }
  DI void copy(const bf16_t* cs, int m0, int n0) const { copy_tile<256>(cs, C, ldc, m0, n0, nvalid); }
};
struct EpiSwiglu {
  bf16_t* C;
  DI void stage(f32x16 (&acc)[4][2], bf16_t* cs, int wr0, int wc0, int m0, int n0, int l31, int hh) const {
#pragma unroll
    for (int mb = 0; mb < 4; mb++)
#pragma unroll
      for (int g = 0; g < 4; g++) {
        const float v0 = siluf(acc[mb][0][4 * g + 0]) * acc[mb][1][4 * g + 0];
        const float v1 = siluf(acc[mb][0][4 * g + 1]) * acc[mb][1][4 * g + 1];
        const float v2 = siluf(acc[mb][0][4 * g + 2]) * acc[mb][1][4 * g + 2];
        const float v3 = siluf(acc[mb][0][4 * g + 3]) * acc[mb][1][4 * g + 3];
        *(uint2*)(cs + (wr0 + mb * 32 + l31) * CLS + (wc0 >> 1) + 8 * g + 4 * hh) = make_uint2(pack2(v0, v1), pack2(v2, v3));
      }
  }
  DI void copy(const bf16_t* cs, int m0, int n0) const { copy_tile<128>(cs, C, 2816, m0, n0 >> 1, 2816); }
};
struct EpiQRope {
  bf16_t* C; const float2* tab;
  DI void stage(f32x16 (&acc)[4][2], bf16_t* cs, int wr0, int wc0, int m0, int n0, int l31, int hh) const {
#pragma unroll
    for (int nb = 0; nb < 2; nb++) {
      const int cb = ((n0 + wc0) >> 5) + nb;
      if ((cb % 3) == 2) {
#pragma unroll
        for (int mb = 0; mb < 4; mb++) {
          const int pos = (m0 + wr0 + mb * 32 + l31) & (S_ - 1);
#pragma unroll
          for (int r = 0; r < 8; r++) {
            const float2 sc = tab[pos * 16 + crow(r, hh)];
            const float t1 = acc[mb][nb][r], t2 = acc[mb][nb][r + 8];
            acc[mb][nb][r] = t1 * sc.x - t2 * sc.y;
            acc[mb][nb][r + 8] = t2 * sc.x + t1 * sc.y;
          }
        }
      }
    }
#pragma unroll
    for (int mb = 0; mb < 4; mb++)
#pragma unroll
      for (int nb = 0; nb < 2; nb++)
#pragma unroll
        for (int g = 0; g < 4; g++)
          *(uint2*)(cs + (wr0 + mb * 32 + l31) * CLS + wc0 + nb * 32 + 8 * g + 4 * hh) =
              make_uint2(pack2(acc[mb][nb][4 * g], acc[mb][nb][4 * g + 1]), pack2(acc[mb][nb][4 * g + 2], acc[mb][nb][4 * g + 3]));
  }
  DI void copy(const bf16_t* cs, int m0, int n0) const { copy_tile<256>(cs, C, 768, m0, n0, 768); }
};

template <class Epi>
DI void phase_gemm(const bf16_t* A, int lda, const bf16_t* Bt, int K, int ntn, char* smem, const Epi& epi) {
  const int G = gridDim.x;
  if ((G & 7) == 0) {
    const int xcd = blockIdx.x & 7, j = blockIdx.x >> 3, nbx = G >> 3;
    const int per = 16 * ntn;
    for (int s = j; s < per; s += nbx) {
      const int g = s / (ntn * 4), r = s % (ntn * 4);
      const int n = r >> 2, mi = r & 3;
      gemm_tile(A, lda, Bt, K, (xcd * 16 + g * 4 + mi) * 256, n * 256, smem, epi);
    }
  } else {
    for (int t = blockIdx.x; t < 128 * ntn; t += G) gemm_tile(A, lda, Bt, K, (t / ntn) * 256, (t % ntn) * 256, smem, epi);
  }
}

template <int DQK>
DI void attn_tile(char* smem, const bf16_t* __restrict__ qp, int q_ld, const bf16_t* __restrict__ kp, int k_ld,
                  const bf16_t* __restrict__ k2p, int k2_ld, const bf16_t* __restrict__ vp, int v_ld,
                  long tok_base, int tok_stride, int q0, int kv_lo, int kv_hi, int win, float scale2, float slope2,
                  int mode, float sink2, float* st_o, float* st_ml, int st_h, bf16_t* outp, int out_ld) {
  constexpr int KS = DQK + 8, VS = 72, NKS = DQK / 16, CPR = DQK / 8;
  bf16_t* Ks = (bf16_t*)smem;
  bf16_t* Vs = Ks + 64 * KS;
  const int tid = threadIdx.x, lane = tid & 63, w = tid >> 6, l31 = lane & 31, hh = lane >> 5;
  const int qi = q0 + w * 32 + l31;
  const long qtok = tok_base + (long)qi * tok_stride;
  bf16x8 qf[NKS];
#pragma unroll
  for (int ks = 0; ks < NKS; ks++) qf[ks] = *(const bf16x8*)(qp + qtok * q_ld + ks * 16 + hh * 8);
  f32x16 o[2];
  float m = -1e30f, l = 0.f;
  if (mode == 2 || mode == 3) {
#pragma unroll
    for (int mb = 0; mb < 2; mb++)
#pragma unroll
      for (int g = 0; g < 4; g++) {
        const float4 v = *(const float4*)(st_o + qtok * 512 + st_h * 64 + mb * 32 + 8 * g + 4 * hh);
        o[mb][4 * g + 0] = v.x; o[mb][4 * g + 1] = v.y; o[mb][4 * g + 2] = v.z; o[mb][4 * g + 3] = v.w;
      }
    m = st_ml[qtok * 8 + st_h];
    l = st_ml[(long)T_ * 8 + qtok * 8 + st_h];
  } else {
#pragma unroll
    for (int mb = 0; mb < 2; mb++)
#pragma unroll
      for (int r = 0; r < 16; r++) o[mb][r] = 0.f;
  }
  const int q_lo = q0 + w * 32, q_hi = q_lo + 31;
  const int q4 = (lane & 15) >> 2, p4 = lane & 3, blk = (lane >> 4) & 1;

  const int kr0 = tid / CPR, kc0 = tid % CPR;
  const int kr1 = (tid + 512) / CPR, kc1 = (tid + 512) % CPR;
  const int vr = tid >> 3, vc = tid & 7;
  uint4 rk0, rk1 = make_uint4(0, 0, 0, 0), rv;
#define ATT_LOAD(KV0)                                                                                          \
  {                                                                                                            \
    const long t0 = tok_base + (long)((KV0) + kr0) * tok_stride;                                               \
    rk0 = (DQK == 96 && kc0 >= 8) ? *(const uint4*)(k2p + t0 * k2_ld + (kc0 - 8) * 8) : *(const uint4*)(kp + t0 * k_ld + kc0 * 8); \
    if (DQK == 96 && tid < 256) {                                                                              \
      const long t1 = tok_base + (long)((KV0) + kr1) * tok_stride;                                             \
      rk1 = (kc1 >= 8) ? *(const uint4*)(k2p + t1 * k2_ld + (kc1 - 8) * 8) : *(const uint4*)(kp + t1 * k_ld + kc1 * 8); \
    }                                                                                                          \
    const long t2 = tok_base + (long)((KV0) + vr) * tok_stride;                                                \
    rv = *(const uint4*)(vp + t2 * v_ld + vc * 8);                                                             \
  }
  ATT_LOAD(kv_lo)
  for (int kv0 = kv_lo; kv0 < kv_hi; kv0 += 64) {
    __syncthreads();
    *(uint4*)(Ks + kr0 * KS + kc0 * 8) = rk0;
    if (DQK == 96 && tid < 256) *(uint4*)(Ks + kr1 * KS + kc1 * 8) = rk1;
    *(uint4*)(Vs + vr * VS + vc * 8) = rv;
    __syncthreads();
    if (kv0 + 64 < kv_hi) ATT_LOAD(kv0 + 64)
    if (kv0 > q_hi || kv0 + 63 < q_lo - win) continue;

    f32x16 s[2];
#pragma unroll
    for (int kb = 0; kb < 2; kb++) {
#pragma unroll
      for (int r = 0; r < 16; r++) s[kb][r] = 0.f;
#pragma unroll
      for (int ks = 0; ks < NKS; ks++) {
        const bf16x8 a = lds_frag(Ks, KS, kb * 32, ks * 16, l31, hh);
        s[kb] = MFMA32(a, qf[ks], s[kb]);
      }
    }
    const bool full = (kv0 + 63 <= q_lo) && (kv0 >= q_hi - win) && (slope2 == 0.f);
    float mx = -INFINITY;
    if (full) {
#pragma unroll
      for (int kb = 0; kb < 2; kb++)
#pragma unroll
        for (int r = 0; r < 16; r++) { s[kb][r] *= scale2; mx = fmaxf(mx, s[kb][r]); }
    } else {
#pragma unroll
      for (int kb = 0; kb < 2; kb++)
#pragma unroll
        for (int r = 0; r < 16; r++) {
          const int rel = qi - (kv0 + kb * 32 + crow(r, hh));
          float v = s[kb][r] * scale2 - slope2 * (float)rel;
          v = (rel >= 0 && rel <= win) ? v : -INFINITY;
          s[kb][r] = v; mx = fmaxf(mx, v);
        }
    }
    mx = fmaxf(mx, __shfl_xor(mx, 32));
    const float mn = fmaxf(m, mx);
    const float alpha = ex2(m - mn);
    m = mn;
    float rs = 0.f;
#pragma unroll
    for (int kb = 0; kb < 2; kb++)
#pragma unroll
      for (int r = 0; r < 16; r++) { const float pv = ex2(s[kb][r] - mn); s[kb][r] = pv; rs += pv; }
    rs += __shfl_xor(rs, 32);
    l = l * alpha + rs;
#pragma unroll
    for (int mb = 0; mb < 2; mb++)
#pragma unroll
      for (int r = 0; r < 16; r++) o[mb][r] *= alpha;
#pragma unroll
    for (int kb = 0; kb < 2; kb++)
#pragma unroll
      for (int st = 0; st < 2; st++) {
        const bf16x8 pb = pack8(s[kb][8 * st + 0], s[kb][8 * st + 1], s[kb][8 * st + 2], s[kb][8 * st + 3],
                                s[kb][8 * st + 4], s[kb][8 * st + 5], s[kb][8 * st + 6], s[kb][8 * st + 7]);
#pragma unroll
        for (int mb = 0; mb < 2; mb++) {
          const bf16_t* base = Vs + (kb * 32 + 16 * st + 4 * hh + q4) * VS + mb * 32 + 16 * blk + 4 * p4;
          const s16x4 lo = tr_read(base);
          const s16x4 hi = tr_read(base + 8 * VS);
          const bf16x8 a = __builtin_shufflevector(lo, hi, 0, 1, 2, 3, 4, 5, 6, 7);
          o[mb] = MFMA32(a, pb, o[mb]);
        }
      }
  }
#undef ATT_LOAD
  if (mode == 1 || mode == 2) {
#pragma unroll
    for (int mb = 0; mb < 2; mb++)
#pragma unroll
      for (int g = 0; g < 4; g++)
        *(float4*)(st_o + qtok * 512 + st_h * 64 + mb * 32 + 8 * g + 4 * hh) =
            make_float4(o[mb][4 * g + 0], o[mb][4 * g + 1], o[mb][4 * g + 2], o[mb][4 * g + 3]);
    if (hh == 0) { st_ml[qtok * 8 + st_h] = m; st_ml[(long)T_ * 8 + qtok * 8 + st_h] = l; }
  } else {
    float mult;
    if (mode == 4) {
      const float mf = fmaxf(m, sink2);
      const float a = ex2(m - mf);
      mult = a * rcpf(l * a + ex2(sink2 - mf));
    } else {
      mult = rcpf(l);
    }
#pragma unroll
    for (int mb = 0; mb < 2; mb++)
#pragma unroll
      for (int g = 0; g < 4; g++)
        *(uint2*)(outp + qtok * out_ld + mb * 32 + 8 * g + 4 * hh) =
            make_uint2(pack2(o[mb][4 * g + 0] * mult, o[mb][4 * g + 1] * mult), pack2(o[mb][4 * g + 2] * mult, o[mb][4 * g + 3] * mult));
  }
}

DI void attnA_task(const Params& p, char* smem, int tau, int pat) {
  const int dil = (pat == 0) ? 1 : (pat == 1 ? 4 : 16);
  const int ntile = (S_ / dil) >> 8;
  const int bh = tau >> 6, rem = tau & 63;
  const int r = rem / ntile, n = rem % ntile;
  const int b = bh >> 3, h = bh & 7;
  const bf16_t* pj = (const bf16_t*)(p.ws + OFF_BIG);
  const int q0 = n * 256;
  const int kv_lo = (q0 >= 128) ? q0 - 128 : 0;
  const float slope2 = exp2f(-(float)(h + 1)) * (float)dil * LOG2E;
  const int mode = (pat == 0) ? 1 : (pat == 1 ? 2 : 3);
  attn_tile<64>(smem, pj + h * 64, 3088, pj + 512 + h * 64, 3088, nullptr, 0, pj + 1024 + h * 64, 3088,
                (long)b * S_ + r, dil, q0, kv_lo, q0 + 256, 128, 0.125f * LOG2E, slope2, mode, 0.f,
                (float*)(p.ws + OFF_HBUF), (float*)(p.ws + OFF_ML), h,
                (bf16_t*)(p.ws + OFF_MIX) + h * 64, 1024);
}

DI void attnC_task(const Params& p, char* smem, int tau) {
  const int b = tau >> 9, hq = (tau >> 6) & 7, tile = tau & 63;
  const int kvh = hq >> 2;
  const bf16_t* pj = (const bf16_t*)(p.ws + OFF_P1);
  const int q0 = tile * 256;
  const int kv_lo = (q0 >= 128) ? q0 - 128 : 0;
  attn_tile<64>(smem, pj + hq * 64, 1440, pj + 512 + kvh * 64, 1440, nullptr, 0, pj + 640 + kvh * 64, 1440,
                (long)b * S_, 1, q0, kv_lo, q0 + 256, 127, 0.125f * LOG2E, exp2f(-(float)(hq + 1)) * LOG2E, 4,
                p.sinks[hq] * LOG2E, nullptr, nullptr, 0, (bf16_t*)(p.ws + OFF_MIX) + hq * 64, 1024);
}

DI void attnD_task(const Params& p, char* smem, int tau) {
  const int bh = tau >> 5, i = tau & 31;
  const int b = bh >> 3, h = bh & 7;
  const bf16_t* qb = (const bf16_t*)(p.ws + OFF_Q);
  const bf16_t* kv = (const bf16_t*)(p.ws + OFF_KV);
  const bf16_t* kpe = (const bf16_t*)(p.ws + OFF_KPE);
  const float scale2 = 0.10206207261596575f * LOG2E;
#pragma unroll 1
  for (int u = 0; u < 2; u++) {
    const int tile = u ? i : (63 - i);
    const int q0 = tile * 256;
    attn_tile<96>(smem, qb + h * 96, 768, kv + h * 128, 1024, kpe, 32, kv + h * 128 + 64, 1024,
                  (long)b * S_, 1, q0, 0, q0 + 256, 1 << 30, scale2, 0.f, 0, 0.f, nullptr, nullptr, 0,
                  (bf16_t*)(p.ws + OFF_MIX) + 512 + h * 64, 1024);
  }
}

DI void gla_gate(const Params& p, float* bc, long tok0, int h, int tid) {
  const bf16_t* pj = (const bf16_t*)(p.ws + OFF_BIG);
  const int d = tid & 63, sg = tid >> 6;
  float wc[16];
#pragma unroll
  for (int r = 0; r < 16; r++) wc[r] = p.gla_wg[r * 256 + h * 64 + d];
  const float bias = p.gla_bg[h * 64 + d];
#pragma unroll 1
  for (int i = 0; i < 16; i++) {
    const int s = sg * 16 + i;
    const uint4* gp = (const uint4*)(pj + (tok0 + s) * 3088 + 3072);
    const uint4 g0 = gp[0], g1 = gp[1];
    float x = bias;
    x += bflo(g0.x) * wc[0] + bfhi(g0.x) * wc[1] + bflo(g0.y) * wc[2] + bfhi(g0.y) * wc[3];
    x += bflo(g0.z) * wc[4] + bfhi(g0.z) * wc[5] + bflo(g0.w) * wc[6] + bfhi(g0.w) * wc[7];
    x += bflo(g1.x) * wc[8] + bfhi(g1.x) * wc[9] + bflo(g1.y) * wc[10] + bfhi(g1.y) * wc[11];
    x += bflo(g1.z) * wc[12] + bfhi(g1.z) * wc[13] + bflo(g1.w) * wc[14] + bfhi(g1.w) * wc[15];
    const float ls = fminf(x, 0.f) - __logf(1.f + __expf(-fabsf(x)));
    bc[s * 64 + d] = ls * (1.f / 16.f);
  }
  __syncthreads();
  if (tid < 64) {
    float c = 0.f;
#pragma unroll 8
    for (int s = 0; s < 64; s++) { c += bc[s * 64 + tid]; bc[s * 64 + tid] = c; }
  }
  __syncthreads();
}

DI void gla_stage_vt(const Params& p, bf16_t* Vt, long tok0, int h, int tid) {
  const bf16_t* pj = (const bf16_t*)(p.ws + OFF_BIG);
  const int e = tid & 127, sg2 = tid >> 7;
  unsigned wv[16];
#pragma unroll
  for (int j = 0; j < 16; j++) {
    const unsigned lo = pj[(tok0 + sg2 * 32 + 2 * j) * 3088 + 2048 + h * 128 + e];
    const unsigned hi = pj[(tok0 + sg2 * 32 + 2 * j + 1) * 3088 + 2048 + h * 128 + e];
    wv[j] = lo | (hi << 16);
  }
  uint4* dp = (uint4*)(Vt + e * 72 + sg2 * 32);
  dp[0] = make_uint4(wv[0], wv[1], wv[2], wv[3]);
  dp[1] = make_uint4(wv[4], wv[5], wv[6], wv[7]);
  dp[2] = make_uint4(wv[8], wv[9], wv[10], wv[11]);
  dp[3] = make_uint4(wv[12], wv[13], wv[14], wv[15]);
}

DI void gla_a_task(const Params& p, char* smem, int task) {
  const int tid = threadIdx.x & 255, lane = tid & 63, w = tid >> 6, l31 = lane & 31, hh = lane >> 5;
  smem += (threadIdx.x >> 8) * 73728;
  const int bh = task >> 8, n = task & 255, b = bh >> 2, h = bh & 3;
  const long tok0 = (long)b * S_ + n * 64;
  float* bc = (float*)smem;
  bf16_t* Vt = (bf16_t*)(smem + 34816);
  bf16_t* KdT = (bf16_t*)(smem + 53248);
  const bf16_t* pj = (const bf16_t*)(p.ws + OFF_BIG);
  gla_gate(p, bc, tok0, h, tid);
  {
    const int d = tid & 63, sg = tid >> 6;
    const float bl = bc[63 * 64 + d];
    unsigned wv[8];
#pragma unroll
    for (int j = 0; j < 8; j++) {
      const int s0 = sg * 16 + 2 * j;
      const float k0 = bf2f(pj[(tok0 + s0) * 3088 + 1792 + h * 64 + d]) * __expf(bl - bc[s0 * 64 + d]);
      const float k1 = bf2f(pj[(tok0 + s0 + 1) * 3088 + 1792 + h * 64 + d]) * __expf(bl - bc[(s0 + 1) * 64 + d]);
      wv[j] = pack2(k0, k1);
    }
    uint4* dp = (uint4*)(KdT + d * 72 + sg * 16);
    dp[0] = make_uint4(wv[0], wv[1], wv[2], wv[3]);
    dp[1] = make_uint4(wv[4], wv[5], wv[6], wv[7]);
  }
  gla_stage_vt(p, Vt, tok0, h, tid);
  __syncthreads();
  f32x16 acc[2];
#pragma unroll
  for (int nb = 0; nb < 2; nb++)
#pragma unroll
    for (int r = 0; r < 16; r++) acc[nb][r] = 0.f;
#pragma unroll
  for (int ks = 0; ks < 4; ks++) {
    const bf16x8 a = lds_frag(Vt, 72, w * 32, ks * 16, l31, hh);
#pragma unroll
    for (int nb = 0; nb < 2; nb++) {
      const bf16x8 bb = lds_frag(KdT, 72, nb * 32, ks * 16, l31, hh);
      acc[nb] = MFMA32(a, bb, acc[nb]);
    }
  }
  float* dst = (float*)((char*)p.out + OUT_DST) + (long)task * 8192;
#pragma unroll
  for (int nb = 0; nb < 2; nb++)
#pragma unroll
    for (int r = 0; r < 16; r++) dst[(w * 32 + crow(r, hh)) * 64 + nb * 32 + l31] = acc[nb][r];
  if (tid < 64) ((float*)((char*)p.out + OUT_DEC))[task * 64 + tid] = __expf(bc[63 * 64 + tid]);
  __syncthreads();
}

DI void gla_scan_item(const Params& p, int item) {
  const int idx = item * NTHR + threadIdx.x;
  const int bh = idx >> 13, ed = idx & 8191, d = ed & 63;
  const float* dS = (const float*)((char*)p.out + OUT_DST);
  const float* dec = (const float*)((char*)p.out + OUT_DEC);
  bf16_t* sp = (bf16_t*)((char*)p.out + OUT_SPT);
  float st = 0.f;
#pragma unroll 1
  for (int n = 0; n < 256; n += 8) {
    float ds[8], dc[8];
#pragma unroll
    for (int u = 0; u < 8; u++) {
      const long task = bh * 256 + n + u;
      ds[u] = dS[task * 8192 + ed];
      dc[u] = dec[task * 64 + d];
    }
#pragma unroll
    for (int u = 0; u < 8; u++) {
      const long task = bh * 256 + n + u;
      sp[task * 8192 + ed] = f2bf(st);
      st = dc[u] * st + ds[u];
    }
  }
}

DI void gla_c_task(const Params& p, char* smem, int task) {
  const int tid = threadIdx.x & 255, lane = tid & 63, w = tid >> 6, l31 = lane & 31, hh = lane >> 5;
  smem += (threadIdx.x >> 8) * 73728;
  const int bh = task >> 8, n = task & 255, b = bh >> 2, h = bh & 3;
  const long tok0 = (long)b * S_ + n * 64;
  float* bc = (float*)smem;
  bf16_t* att = (bf16_t*)smem;
  bf16_t* Qg = (bf16_t*)(smem + 16384);
  bf16_t* Kg = (bf16_t*)(smem + 25600);
  bf16_t* Vt = (bf16_t*)(smem + 34816);
  bf16_t* SpT = (bf16_t*)(smem + 53248);
  float* red = (float*)(smem + 71680);
  const bf16_t* pj = (const bf16_t*)(p.ws + OFF_BIG);
  gla_gate(p, bc, tok0, h, tid);
  {
    const int d = tid & 63, sg = tid >> 6;
    const float bm = bc[31 * 64 + d];
#pragma unroll 4
    for (int i = 0; i < 16; i++) {
      const int s = sg * 16 + i;
      const float bb = bc[s * 64 + d];
      const float qv = bf2f(pj[(tok0 + s) * 3088 + 1536 + h * 64 + d]);
      const float kv = bf2f(pj[(tok0 + s) * 3088 + 1792 + h * 64 + d]);
      Qg[s * 72 + d] = f2bf(qv * 0.125f * __expf(bb - bm));
      Kg[s * 72 + d] = f2bf(kv * __expf(bm - bb));
    }
  }
  gla_stage_vt(p, Vt, tok0, h, tid);
  {
    const int e = tid >> 1, hf = tid & 1;
    const uint4* sp = (const uint4*)((const bf16_t*)((char*)p.out + OUT_SPT) + (long)task * 8192 + e * 64 + hf * 32);
    uint4* dp = (uint4*)(SpT + e * 72 + hf * 32);
#pragma unroll
    for (int c = 0; c < 4; c++) {
      const uint4 v = sp[c];
      const int d0 = hf * 32 + c * 8;
      uint4 o;
      o.x = pack2(bflo(v.x) * __expf(bc[31 * 64 + d0 + 0]), bfhi(v.x) * __expf(bc[31 * 64 + d0 + 1]));
      o.y = pack2(bflo(v.y) * __expf(bc[31 * 64 + d0 + 2]), bfhi(v.y) * __expf(bc[31 * 64 + d0 + 3]));
      o.z = pack2(bflo(v.z) * __expf(bc[31 * 64 + d0 + 4]), bfhi(v.z) * __expf(bc[31 * 64 + d0 + 5]));
      o.w = pack2(bflo(v.w) * __expf(bc[31 * 64 + d0 + 6]), bfhi(v.w) * __expf(bc[31 * 64 + d0 + 7]));
      dp[c] = o;
    }
  }
  __syncthreads();
  {
    const int mb = w & 1, nb = w >> 1;
    f32x16 a2;
#pragma unroll
    for (int r = 0; r < 16; r++) a2[r] = 0.f;
#pragma unroll
    for (int ks = 0; ks < 4; ks++) {
      const bf16x8 a = lds_frag(Qg, 72, mb * 32, ks * 16, l31, hh);
      const bf16x8 bb = lds_frag(Kg, 72, nb * 32, ks * 16, l31, hh);
      a2 = MFMA32(a, bb, a2);
    }
#pragma unroll
    for (int r = 0; r < 16; r++) {
      const int c = mb * 32 + crow(r, hh), s = nb * 32 + l31;
      att[c * 72 + s] = f2bf((s <= c) ? a2[r] : 0.f);
    }
  }
  __syncthreads();
  f32x16 acc[2];
#pragma unroll
  for (int nb = 0; nb < 2; nb++)
#pragma unroll
    for (int r = 0; r < 16; r++) acc[nb][r] = 0.f;
#pragma unroll
  for (int ks = 0; ks < 4; ks++) {
    const bf16x8 a = lds_frag(Vt, 72, w * 32, ks * 16, l31, hh);
#pragma unroll
    for (int nb = 0; nb < 2; nb++) acc[nb] = MFMA32(a, lds_frag(att, 72, nb * 32, ks * 16, l31, hh), acc[nb]);
  }
#pragma unroll
  for (int ks = 0; ks < 4; ks++) {
    const bf16x8 a = lds_frag(SpT, 72, w * 32, ks * 16, l31, hh);
#pragma unroll
    for (int nb = 0; nb < 2; nb++) acc[nb] = MFMA32(a, lds_frag(Qg, 72, nb * 32, ks * 16, l31, hh), acc[nb]);
  }
#pragma unroll
  for (int nb = 0; nb < 2; nb++) {
    float ss = 0.f;
#pragma unroll
    for (int r = 0; r < 16; r++) ss += acc[nb][r] * acc[nb][r];
    ss += __shfl_xor(ss, 32);
    if (hh == 0) red[w * 64 + nb * 32 + l31] = ss;
  }
  __syncthreads();
  bf16_t* mix = (bf16_t*)(p.ws + OFF_MIX);
#pragma unroll
  for (int nb = 0; nb < 2; nb++) {
    const int c = nb * 32 + l31;
    const float tot = red[c] + red[64 + c] + red[128 + c] + red[192 + c];
    const float rn = rsqrtf(tot * (1.f / 128.f) + 1e-6f);
    const long tok = tok0 + c;
#pragma unroll
    for (int g = 0; g < 4; g++) {
      const int e0 = w * 32 + 8 * g + 4 * hh;
      const float4 gn = *(const float4*)(p.gla_norm + e0);
      const uint2 rr = *(const uint2*)(pj + tok * 3088 + 2560 + h * 128 + e0);
      const float o0 = acc[nb][4 * g + 0] * rn * gn.x * siluf(bflo(rr.x));
      const float o1 = acc[nb][4 * g + 1] * rn * gn.y * siluf(bfhi(rr.x));
      const float o2 = acc[nb][4 * g + 2] * rn * gn.z * siluf(bflo(rr.y));
      const float o3 = acc[nb][4 * g + 3] * rn * gn.w * siluf(bfhi(rr.y));
      *(uint2*)(mix + tok * 1024 + 512 + h * 128 + e0) = make_uint2(pack2(o0, o1), pack2(o2, o3));
    }
  }
  __syncthreads();
}

DI void phase_latent(const Params& p) {
  const int lane = threadIdx.x & 63, w = threadIdx.x >> 6;
  const bf16_t* pj = (const bf16_t*)(p.ws + OFF_P1);
  bf16_t* cqn = (bf16_t*)(p.ws + OFF_CQN);
  bf16_t* ckvn = (bf16_t*)(p.ws + OFF_CKVN);
  bf16_t* kpe = (bf16_t*)(p.ws + OFF_KPE);
  const float2* tab = (const float2*)(p.ws + OFF_ROPE);
  for (int row = blockIdx.x * 8 + w; row < T_; row += gridDim.x * 8) {
    const bf16_t* pr = pj + (long)row * 1440;
    uint4 a = make_uint4(0, 0, 0, 0), c = make_uint4(0, 0, 0, 0);
    if (lane < 48) a = *(const uint4*)(pr + 768 + lane * 8);
    if (lane < 32) c = *(const uint4*)(pr + 1152 + lane * 8);
    float av[8] = {bflo(a.x), bfhi(a.x), bflo(a.y), bfhi(a.y), bflo(a.z), bfhi(a.z), bflo(a.w), bfhi(a.w)};
    float cv[8] = {bflo(c.x), bfhi(c.x), bflo(c.y), bfhi(c.y), bflo(c.z), bfhi(c.z), bflo(c.w), bfhi(c.w)};
    float sa = 0.f, sc = 0.f;
#pragma unroll
    for (int j = 0; j < 8; j++) { sa += av[j] * av[j]; sc += cv[j] * cv[j]; }
    sa = wave_sum(sa); sc = wave_sum(sc);
    const float ra = rsqrtf(sa * (1.f / 384.f) + 1e-6f), rc = rsqrtf(sc * (1.f / 256.f) + 1e-6f);
    if (lane < 48) {
      const float4 g0 = *(const float4*)(p.q_norm + lane * 8), g1 = *(const float4*)(p.q_norm + lane * 8 + 4);
      *(uint4*)(cqn + (long)row * 384 + lane * 8) =
          make_uint4(pack2(av[0] * ra * g0.x, av[1] * ra * g0.y), pack2(av[2] * ra * g0.z, av[3] * ra * g0.w),
                     pack2(av[4] * ra * g1.x, av[5] * ra * g1.y), pack2(av[6] * ra * g1.z, av[7] * ra * g1.w));
    }
    if (lane < 32) {
      const float4 g0 = *(const float4*)(p.kv_norm + lane * 8), g1 = *(const float4*)(p.kv_norm + lane * 8 + 4);
      *(uint4*)(ckvn + (long)row * 256 + lane * 8) =
          make_uint4(pack2(cv[0] * rc * g0.x, cv[1] * rc * g0.y), pack2(cv[2] * rc * g0.z, cv[3] * rc * g0.w),
                     pack2(cv[4] * rc * g1.x, cv[5] * rc * g1.y), pack2(cv[6] * rc * g1.z, cv[7] * rc * g1.w));
    }
    if (lane < 16) {
      const float t1 = bf2f(pr[1408 + lane]), t2 = bf2f(pr[1408 + 16 + lane]);
      const float2 cs = tab[(row & (S_ - 1)) * 16 + lane];
      kpe[(long)row * 32 + lane] = f2bf(t1 * cs.x - t2 * cs.y);
      kpe[(long)row * 32 + 16 + lane] = f2bf(t2 * cs.x + t1 * cs.y);
    }
  }
}

__global__ void __launch_bounds__(NTHR, 2) mega_kernel(Params p) {
  __shared__ __attribute__((aligned(16))) char smem[LDS_BYTES];
  cg::grid_group grid = cg::this_grid();
  char* ws = p.ws;
  bf16_t* hbuf = (bf16_t*)(ws + OFF_HBUF);
  bf16_t* mix = (bf16_t*)(ws + OFF_MIX);
  bf16_t* big = (bf16_t*)(ws + OFF_BIG);
  const int G = gridDim.x, bid = blockIdx.x, grp = threadIdx.x >> 8;

  phase_convert(p, smem);
  phase_rope_table(p);
  phase_rms_first(p.x, p.n_mix_pre, hbuf);
  grid.sync();
  phase_gemm(hbuf, 1024, (const bf16_t*)(ws + OFF_W0IN), 1024, 13, smem, EpiStore{big, 3088, 3088});
  grid.sync();
  for (int t = bid; t < 2048; t += G) { if (t < 1024) gla_a_task(p, smem, 2 * t + grp); else attnA_task(p, smem, t - 1024, 0); }
  grid.sync();
  for (int t = bid; t < 128 + 1024; t += G) { if (t < 128) gla_scan_item(p, t); else attnA_task(p, smem, t - 128, 1); }
  grid.sync();
  for (int t = bid; t < 2048; t += G) { if (t < 1024) gla_c_task(p, smem, 2 * t + grp); else attnA_task(p, smem, t - 1024, 2); }
  grid.sync();
  phase_gemm(mix, 1024, (const bf16_t*)(ws + OFF_W0OUT), 1024, 4, smem, EpiStore{hbuf, 1024, 1024});
  grid.sync();
  phase_resid(p.x, p.out, hbuf, p.n_mix_post, p.n_ffn_pre);
  grid.sync();
  phase_gemm(hbuf, 1024, (const bf16_t*)(ws + OFF_WGU0), 1024, 22, smem, EpiSwiglu{big});
  grid.sync();
  phase_gemm(big, 2816, (const bf16_t*)(ws + OFF_WDN0), 2816, 4, smem, EpiStore{hbuf, 1024, 1024});
  grid.sync();
  phase_resid(p.out, p.out, hbuf, p.n_ffn_post, p.n_mix_pre + 1024);
  grid.sync();
  phase_gemm(hbuf, 1024, (const bf16_t*)(ws + OFF_W1IN), 1024, 6, smem, EpiStore{(bf16_t*)(ws + OFF_P1), 1440, 1440});
  grid.sync();
  phase_latent(p);
  grid.sync();
  {
    const EpiQRope eq{(bf16_t*)(ws + OFF_Q), (const float2*)(ws + OFF_ROPE)};
    const EpiStore ekv{(bf16_t*)(ws + OFF_KV), 1024, 1024};
    phase_gemm((const bf16_t*)(ws + OFF_CQN), 384, (const bf16_t*)(ws + OFF_WUQ), 384, 3, smem, eq);
    phase_gemm((const bf16_t*)(ws + OFF_CKVN), 256, (const bf16_t*)(ws + OFF_WUKV), 256, 4, smem, ekv);
  }
  grid.sync();
  for (int t = bid; t < 512 + 1024; t += G) { if (t < 512) attnD_task(p, smem, t); else attnC_task(p, smem, t - 512); }
  grid.sync();
  phase_gemm(mix, 1024, (const bf16_t*)(ws + OFF_W1OUT), 1024, 4, smem, EpiStore{hbuf, 1024, 1024});
  grid.sync();
  phase_resid(p.out, p.out, hbuf, p.n_mix_post + 1024, p.n_ffn_pre + 1024);
  grid.sync();
  phase_gemm(hbuf, 1024, (const bf16_t*)(ws + OFF_WGU1), 1024, 22, smem, EpiSwiglu{big});
  grid.sync();
  phase_gemm(big, 2816, (const bf16_t*)(ws + OFF_WDN1), 2816, 4, smem, EpiStore{hbuf, 1024, 1024});
  grid.sync();
  phase_resid(p.out, p.out, hbuf, p.n_ffn_post + 1024, nullptr);
}

extern "C" void kernel_launch(void* const* d_in, const int* in_sizes, int n_in, void* d_out, int out_size, void* d_ws,
                              size_t ws_size, hipStream_t stream) {
  static int grid_blocks = 0;
  if (!grid_blocks) {
    int dev = 0, cus = 0, per_cu = 0;
    hipGetDevice(&dev);
    hipDeviceGetAttribute(&cus, hipDeviceAttributeMultiprocessorCount, dev);
    hipOccupancyMaxActiveBlocksPerMultiprocessor(&per_cu, mega_kernel, NTHR, 0);
    if (per_cu < 1) per_cu = 1;
    grid_blocks = cus * per_cu;
  }
  if (ws_size < (size_t)WS_NEED) { fprintf(stderr, "workspace too small: %zu < %ld\n", ws_size, (long)WS_NEED); return; }
  Params p{};
  const float** f = (const float**)&p;
  for (int i = 0; i < 20; i++) f[i] = (const float*)d_in[i];
  p.out = (float*)d_out;
  p.ws = (char*)d_ws;
  void* args[] = {&p};
  hipError_t e = hipLaunchCooperativeKernel((void*)mega_kernel, dim3(grid_blocks), dim3(NTHR), args, 0, stream);
  if (e != hipSuccess) fprintf(stderr, "cooperative launch failed: %s (grid %d)\n", hipGetErrorString(e), grid_blocks);
}
```

```cpp
#include <hip/hip_runtime.h>
#include <hip/hip_cooperative_groups.h>
#include <cstdio>
namespace cg = cooperative_groups;

typedef unsigned short bf16_t;
using bf16x8 = __attribute__((ext_vector_type(8))) short;
using s16x4  = __attribute__((ext_vector_type(4))) short;
using f32x16 = __attribute__((ext_vector_type(16))) float;
typedef __attribute__((ext_vector_type(2))) __bf16 bf2_t;
#define DI __device__ __forceinline__
#define MFMA32(a, b, c) __builtin_amdgcn_mfma_f32_32x32x16_bf16((a), (b), (c), 0, 0, 0)

constexpr int T_ = 32768, S_ = 16384;
constexpr float LOG2E = 1.4426950408889634f;
constexpr int LDS_BYTES = 147456;
constexpr int NTHR = 512;

constexpr long OFF_W0IN  = 0;
constexpr long OFF_W0OUT = OFF_W0IN  + 3328L * 1024 * 2;
constexpr long OFF_WGU0  = OFF_W0OUT + 1024L * 1024 * 2;
constexpr long OFF_WGU1  = OFF_WGU0  + 5632L * 1024 * 2;
constexpr long OFF_WDN0  = OFF_WGU1  + 5632L * 1024 * 2;
constexpr long OFF_WDN1  = OFF_WDN0  + 1024L * 2816 * 2;
constexpr long OFF_W1IN  = OFF_WDN1  + 1024L * 2816 * 2;
constexpr long OFF_W1OUT = OFF_W1IN  + 1536L * 1024 * 2;
constexpr long OFF_WUQ   = OFF_W1OUT + 1024L * 1024 * 2;
constexpr long OFF_WUKV  = OFF_WUQ   + 768L * 384 * 2;
constexpr long OFF_ROPE  = OFF_WUKV  + 1024L * 256 * 2;
constexpr long OFF_ML    = OFF_ROPE  + 16384L * 16 * 8;
constexpr long OFF_HBUF  = OFF_ML    + (long)T_ * 8 * 4 * 2;
constexpr long OFF_MIX   = OFF_HBUF  + (long)T_ * 1024 * 2;
constexpr long OFF_KV    = OFF_MIX   + (long)T_ * 1024 * 2;
constexpr long OFF_BIG   = OFF_KV    + (long)T_ * 1024 * 2;
constexpr long WS_NEED   = OFF_BIG   + (long)T_ * 3088 * 2;
constexpr long OFF_P1    = OFF_BIG;
constexpr long OFF_CQN   = OFF_P1   + (long)T_ * 1440 * 2;
constexpr long OFF_CKVN  = OFF_CQN  + (long)T_ * 384 * 2;
constexpr long OFF_KPE   = OFF_CKVN + (long)T_ * 256 * 2;
constexpr long OFF_Q     = OFF_KPE  + (long)T_ * 32 * 2;
constexpr long OUT_DST   = 0;
constexpr long OUT_SPT   = 2048L * 8192 * 4;
constexpr long OUT_DEC   = OUT_SPT + 2048L * 8192 * 2;

struct Params {
  const float *x, *n_mix_pre, *n_mix_post, *n_ffn_pre, *n_ffn_post, *ffn_g, *ffn_u, *ffn_d;
  const float *ab_in, *ab_out, *gla_wg, *gla_bg, *gla_norm, *cd_in, *cd_out, *sinks, *q_norm, *w_uq, *kv_norm, *w_ukv;
  float* out;
  char* ws;
};

DI int tidx() { int t = threadIdx.x; asm volatile("" : "+v"(t)); return t; }
DI unsigned pack2(float a, float b) { bf2_t v; v[0] = (__bf16)a; v[1] = (__bf16)b; return __builtin_bit_cast(unsigned, v); }
DI bf16_t f2bf(float a) { return __builtin_bit_cast(unsigned short, (__bf16)a); }
DI float bf2f(bf16_t v) { return __uint_as_float(((unsigned)v) << 16); }
DI float bflo(unsigned u) { return __uint_as_float(u << 16); }
DI float bfhi(unsigned u) { return __uint_as_float(u & 0xffff0000u); }
DI float ex2(float x) { return __builtin_amdgcn_exp2f(x); }
DI float rcpf(float x) { return __builtin_amdgcn_rcpf(x); }
DI float siluf(float x) { return x * rcpf(1.f + __expf(-x)); }
DI int crow(int reg, int hh) { return (reg & 3) + 8 * (reg >> 2) + 4 * hh; }
DI float wave_sum(float v) {
#pragma unroll
  for (int o = 32; o; o >>= 1) v += __shfl_xor(v, o);
  return v;
}
DI bf16x8 pack8(float a0, float a1, float a2, float a3, float a4, float a5, float a6, float a7) {
  uint4 u = make_uint4(pack2(a0, a1), pack2(a2, a3), pack2(a4, a5), pack2(a6, a7));
  return __builtin_bit_cast(bf16x8, u);
}
DI bf16x8 lds_frag(const bf16_t* base, int stride, int row0, int kofs, int l31, int hh) {
  return *(const bf16x8*)(base + (row0 + l31) * stride + kofs + hh * 8);
}
DI s16x4 tr_read(const bf16_t* p) {
  return __builtin_amdgcn_ds_read_tr16_b64_v4i16((__attribute__((address_space(3))) s16x4*)(p));
}

DI void phase_convert(const Params& p, char* smem) {
  const int tid = tidx() & 255, grp = tidx() >> 8;
  float* tl = (float*)(smem + grp * 16640);
  for (int it0 = blockIdx.x * 2; it0 < 6088; it0 += gridDim.x * 2) {
    const int it = it0 + grp;
    const float *sa, *sb; int K, N, mode = 0, t; long doff;
    if (it < 832)       { t = it;        sa = p.ab_in;  sb = sa; K = 1024; N = 3088; doff = OFF_W0IN; }
    else if (it < 1088) { t = it - 832;  sa = p.ab_out; sb = sa; K = 1024; N = 1024; doff = OFF_W0OUT; }
    else if (it < 2496) { t = it - 1088; sa = p.ffn_g;  sb = p.ffn_u; K = 1024; N = 2816; mode = 1; doff = OFF_WGU0; }
    else if (it < 3904) { t = it - 2496; sa = p.ffn_g + 1024L * 2816; sb = p.ffn_u + 1024L * 2816; K = 1024; N = 2816; mode = 1; doff = OFF_WGU1; }
    else if (it < 4608) { t = it - 3904; sa = p.ffn_d;  sb = sa; K = 2816; N = 1024; doff = OFF_WDN0; }
    else if (it < 5312) { t = it - 4608; sa = p.ffn_d + 2816L * 1024; sb = sa; K = 2816; N = 1024; doff = OFF_WDN1; }
    else if (it < 5696) { t = it - 5312; sa = p.cd_in;  sb = sa; K = 1024; N = 1440; doff = OFF_W1IN; }
    else if (it < 5952) { t = it - 5696; sa = p.cd_out; sb = sa; K = 1024; N = 1024; doff = OFF_W1OUT; }
    else if (it < 6024) { t = it - 5952; sa = p.w_uq;   sb = sa; K = 384;  N = 768;  doff = OFF_WUQ; }
    else                { t = it - 6024; sa = p.w_ukv;  sb = sa; K = 256;  N = 1024; doff = OFF_WUKV; }
    bf16_t* dst = (bf16_t*)(p.ws + doff);
    const int nkt = K >> 6;
    const int kt = t % nkt, nt = t / nkt;
    const int k0 = kt * 64, n0 = nt * 64;
    const int nn = tid & 63, kr = tid >> 6;
    const float* src; int col;
    if (mode) { src = ((nt & 3) < 2) ? sa : sb; col = (nt >> 2) * 128 + (nt & 1) * 64 + nn; }
    else      { src = sa; col = n0 + nn; }
    const bool ok = col < N;
#pragma unroll
    for (int i = 0; i < 16; i++) {
      const int kk = i * 4 + kr;
      tl[kk * 65 + nn] = ok ? src[(long)(k0 + kk) * N + col] : 0.f;
    }
    __syncthreads();
    const int n2 = tid >> 2, kq = (tid & 3) * 16;
    unsigned wv[8];
#pragma unroll
    for (int j = 0; j < 8; j++) wv[j] = pack2(tl[(kq + 2 * j) * 65 + n2], tl[(kq + 2 * j + 1) * 65 + n2]);
    uint4* dp = (uint4*)(dst + (long)(n0 + n2) * K + k0 + kq);
    dp[0] = make_uint4(wv[0], wv[1], wv[2], wv[3]);
    dp[1] = make_uint4(wv[4], wv[5], wv[6], wv[7]);
    __syncthreads();
  }
}

DI void phase_rope_table(const Params& p) {
  float2* tab = (float2*)(p.ws + OFF_ROPE);
  for (int i = blockIdx.x * NTHR + tidx(); i < 16384 * 16; i += gridDim.x * NTHR) {
    const int pos = i >> 4, j = i & 15;
    const float freq = exp2f(-(float)j * (13.287712379549449f / 16.f));
    const float ang = (float)pos * freq;
    const double a = (double)ang;
    const double k = rint(a * 0.15915494309189535);
    const float rf = (float)(a - k * 6.283185307179586);
    tab[i] = make_float2(__cosf(rf), __sinf(rf));
  }
}

DI void phase_rms_first(const float* __restrict__ x, const float* __restrict__ g, bf16_t* __restrict__ h) {
  const int lane = tidx() & 63, w = tidx() >> 6;
  for (int row = blockIdx.x * 8 + w; row < T_; row += gridDim.x * 8) {
    const float4* xr = (const float4*)(x + (long)row * 1024);
    float4 v[4]; float ss = 0.f;
#pragma unroll
    for (int i = 0; i < 4; i++) { v[i] = xr[lane + i * 64]; ss += v[i].x * v[i].x + v[i].y * v[i].y + v[i].z * v[i].z + v[i].w * v[i].w; }
    ss = wave_sum(ss);
    const float r = rsqrtf(ss * (1.f / 1024.f) + 1e-6f);
    uint2* hr = (uint2*)(h + (long)row * 1024);
#pragma unroll
    for (int i = 0; i < 4; i++) {
      const float4 gg = ((const float4*)g)[lane + i * 64];
      hr[lane + i * 64] = make_uint2(pack2(v[i].x * r * gg.x, v[i].y * r * gg.y), pack2(v[i].z * r * gg.z, v[i].w * r * gg.w));
    }
  }
}

DI void phase_resid(const float* xin, float* xout, bf16_t* yh, const float* __restrict__ gpost, const float* __restrict__ gnext) {
  const int lane = tidx() & 63, w = tidx() >> 6;
  for (int row = blockIdx.x * 8 + w; row < T_; row += gridDim.x * 8) {
    uint2* yr = (uint2*)(yh + (long)row * 1024);
    const float4* xr = (const float4*)(xin + (long)row * 1024);
    float4* xo = (float4*)(xout + (long)row * 1024);
    float4 y[4]; float ss = 0.f;
#pragma unroll
    for (int i = 0; i < 4; i++) {
      const uint2 u = yr[lane + i * 64];
      y[i] = make_float4(bflo(u.x), bfhi(u.x), bflo(u.y), bfhi(u.y));
      ss += y[i].x * y[i].x + y[i].y * y[i].y + y[i].z * y[i].z + y[i].w * y[i].w;
    }
    ss = wave_sum(ss);
    const float r1 = rsqrtf(ss * (1.f / 1024.f) + 1e-6f);
    float ss2 = 0.f;
#pragma unroll
    for (int i = 0; i < 4; i++) {
      const float4 gg = ((const float4*)gpost)[lane + i * 64];
      const float4 xv = xr[lane + i * 64];
      y[i].x = xv.x + y[i].x * r1 * gg.x; y[i].y = xv.y + y[i].y * r1 * gg.y;
      y[i].z = xv.z + y[i].z * r1 * gg.z; y[i].w = xv.w + y[i].w * r1 * gg.w;
      xo[lane + i * 64] = y[i];
      ss2 += y[i].x * y[i].x + y[i].y * y[i].y + y[i].z * y[i].z + y[i].w * y[i].w;
    }
    if (gnext) {
      ss2 = wave_sum(ss2);
      const float r2 = rsqrtf(ss2 * (1.f / 1024.f) + 1e-6f);
#pragma unroll
      for (int i = 0; i < 4; i++) {
        const float4 gg = ((const float4*)gnext)[lane + i * 64];
        yr[lane + i * 64] = make_uint2(pack2(y[i].x * r2 * gg.x, y[i].y * r2 * gg.y), pack2(y[i].z * r2 * gg.z, y[i].w * r2 * gg.w));
      }
    }
  }
}

namespace pg8 {
#define PG8_LAS __attribute__((address_space(3)))
typedef unsigned short bf16_t;
typedef short bf16x8 __attribute__((ext_vector_type(8)));
typedef float f32x4 __attribute__((ext_vector_type(4)));
typedef unsigned u32x4 __attribute__((ext_vector_type(4)));
constexpr int BM = 256, BK = 64, HALF = 128, HTB = HALF * BK * 2  , STAGE_BYTES = 8 * HTB, NXCD = 8, WGM = 8;

__host__ __device__ __forceinline__ int lds_byte(int r, int c) { const int st = (r >> 4) * 2 + (c >> 5), rr = r & 15, cc = c & 31, ob = rr * 64 + cc * 2; return st * 1024 + (ob ^ (((ob >> 9) & 1) << 5)); }
__host__ __device__ __forceinline__ void stage_rc(int b, int& R, int& C) { const int st = b / 1024, sb = b % 1024, swz = sb ^ (((sb >> 9) & 1) << 5); R = (st >> 1) * 16 + swz / 64; C = (st & 1) * 32 + (swz % 64) / 2; }
__host__ __device__ __forceinline__ int perm32(int rho) { const int n = rho >> 4, i = rho & 15; return 8 * (i >> 2) + 4 * n + (i & 3); }

struct Unit { int pm, pn; };
struct Gemm { const bf16_t* A; const bf16_t* Bt; int M, N, K; };

struct StaticOrder {
    int nM, nN, nwg, G, c;
    __host__ __device__ void init(int M, int N, int G_, int c_) { nM = M / BM; nN = N / BM; nwg = nM * nN; G = G_; c = c_; }
    __host__ __device__ bool next(int i, Unit& u) const {
        const long L = (long)i * G + c; if (L >= nwg) return false;
        int wgid = (int)L; { const int q = nwg / NXCD, r = nwg % NXCD, xcd = wgid % NXCD, off = wgid / NXCD; wgid = (xcd < r ? xcd * (q + 1) : r * (q + 1) + (xcd - r) * q) + off; }
        const int nig = WGM * nN, gid = wgid / nig, fm = gid * WGM, gsz = (nM - fm) < WGM ? (nM - fm) : WGM;
        u.pm = fm + ((wgid % nig) % gsz); u.pn = (wgid % nig) / gsz; return true;
    }
    __device__ __forceinline__ void a_ready(const Unit&) const {}
    __device__ __forceinline__ void done(const Unit&) const {}
};
__device__ __forceinline__ unsigned cvt_pk_bf16(float lo, float hi) { unsigned r; asm volatile("v_cvt_pk_bf16_f32 %0, %1, %2" : "=v"(r) : "v"(lo), "v"(hi)); return r; }
typedef float f32x2 __attribute__((ext_vector_type(2)));

struct EpiStoreP {
    static constexpr bool PERM = true, AFTER_DRAIN = false;
    bf16_t* O; int ldc; int nvalid;
    __device__ __forceinline__ void operator()(const f32x4 (&acc)[2][2][4][2], const Unit& u, int wr, int wc, int fr, int fq) const {
        const int row0 = u.pm * BM + wr * 64 + fr, col0 = u.pn * BM + wc * 32 + 8 * fq;
#pragma unroll
        for (int ai = 0; ai < 2; ++ai)
#pragma unroll
            for (int m = 0; m < 4; ++m) { bf16_t* rowp = O + (size_t)(row0 + ai * HALF + m * 16) * ldc + col0;
#pragma unroll
                for (int bj = 0; bj < 2; ++bj) if (col0 + bj * HALF < nvalid) {
                    const f32x4 v0 = acc[ai][bj][m][0], v1 = acc[ai][bj][m][1];
                    u32x4 w; w.x = cvt_pk_bf16(v0[0], v0[1]); w.y = cvt_pk_bf16(v0[2], v0[3]); w.z = cvt_pk_bf16(v1[0], v1[1]); w.w = cvt_pk_bf16(v1[2], v1[3]);
                    *(u32x4*)(rowp + bj * HALF) = w; } }
    }
};
struct EpiSwigluP {
    static constexpr bool PERM = true, AFTER_DRAIN = false;
    bf16_t* O;
    static __device__ __forceinline__ float sg(float g, float uu) { return g * __builtin_amdgcn_rcpf(1.f + __expf(-g)) * uu; }
    __device__ __forceinline__ void operator()(const f32x4 (&acc)[2][2][4][2], const Unit& u, int wr, int wc, int fr, int fq) const {
        const int row0 = u.pm * BM + wr * 64 + fr, col0 = u.pn * HALF + wc * 32 + 8 * fq;
#pragma unroll
        for (int ai = 0; ai < 2; ++ai)
#pragma unroll
            for (int m = 0; m < 4; ++m) {
                const f32x4 g0 = acc[ai][0][m][0], g1 = acc[ai][0][m][1], u0 = acc[ai][1][m][0], u1 = acc[ai][1][m][1];
                u32x4 w; w.x = cvt_pk_bf16(sg(g0[0], u0[0]), sg(g0[1], u0[1])); w.y = cvt_pk_bf16(sg(g0[2], u0[2]), sg(g0[3], u0[3]));
                w.z = cvt_pk_bf16(sg(g1[0], u1[0]), sg(g1[1], u1[1])); w.w = cvt_pk_bf16(sg(g1[2], u1[2]), sg(g1[3], u1[3]));
                *(u32x4*)(O + (size_t)(row0 + ai * HALF + m * 16) * 2816 + col0) = w; }
    }
};
template <class Epi, class Sched, bool STAMP = false>
__device__ __forceinline__ void gemm_phase(PG8_LAS unsigned char* lds, const Gemm g, const Sched& S, const Epi& E, unsigned long long* stamps) {
    int tid = threadIdx.x; asm volatile("" : "+v"(tid));
    const int wid = __builtin_amdgcn_readfirstlane(tid >> 6), lane = tid & 63, wr = wid >> 2, wc = wid & 3, fr = lane & 15, fq = lane >> 4;
    const int K = g.K, nt = K / BK;
    int ts_lo = 0, ts_hi = 0, nts = 0; const unsigned long long rt_entry = STAMP ? (unsigned long long)wall_clock64() : 0ull;
#define PG8_STAMP() do { if (STAMP && wid == 0 && nts < 64) { const unsigned long long _c = (unsigned long long)clock64(); \
        ts_lo = (lane == nts) ? (int)(unsigned)_c : ts_lo; ts_hi = (lane == nts) ? (int)(unsigned)(_c >> 32) : ts_hi; ++nts; } } while (0)
    PG8_STAMP();
    unsigned voffA[2], voffB[2];
#pragma unroll
    for (int i = 0; i < 2; ++i) { int R, C; stage_rc(tid * 16 + i * 8192, R, C); const int Rb = Epi::PERM ? ((R & ~31) + perm32(R & 31)) : R;
        voffA[i] = (unsigned)(R * K + C) * 2u; voffB[i] = (unsigned)(Rb * K + C) * 2u; }
    const size_t kstep = (size_t)(BK * 2);
    const size_t hstep = (size_t)HALF * K * 2;
    const size_t tstep = 2 * hstep;
    const unsigned ldsw = (unsigned)wid * 1024u;
    const int aoff = lds_byte(wr * 64 + fr, fq * 8), boff = lds_byte(wc * 32 + fr, fq * 8);
#define PG8_SA(b, h) (((b) * 2 + (h)) * HTB)
#define PG8_SB(b, h) ((4 + (b) * 2 + (h)) * HTB)
#define PG8_STAGE(bufoff, gbase, voff) do { _Pragma("unroll") for (int _i = 0; _i < 2; ++_i) \
        __builtin_amdgcn_global_load_lds((const unsigned*)((const char*)(gbase) + (voff)[_i]), (PG8_LAS unsigned*)(lds + (bufoff) + ldsw + _i * 8192), 16, 0, 0); } while (0)
#define PG8_LDA(dst, b, h) do { _Pragma("unroll") for (int m = 0; m < 4; ++m) _Pragma("unroll") for (int k = 0; k < 2; ++k) dst[m][k] = *(const PG8_LAS bf16x8*)(lds + PG8_SA(b, h) + aoff + m * 2048 + k * 1024); } while (0)
#define PG8_LDB(dst, b, h) do { _Pragma("unroll") for (int n = 0; n < 2; ++n) _Pragma("unroll") for (int k = 0; k < 2; ++k) dst[n][k] = *(const PG8_LAS bf16x8*)(lds + PG8_SB(b, h) + boff + n * 2048 + k * 1024); } while (0)
#define PG8_MMA(ai, bj, At, Bt) do { __builtin_amdgcn_s_setprio(1); _Pragma("unroll") for (int m = 0; m < 4; ++m) _Pragma("unroll") for (int n = 0; n < 2; ++n) _Pragma("unroll") for (int k = 0; k < 2; ++k) \
        acc[ai][bj][m][n] = __builtin_amdgcn_mfma_f32_16x16x32_bf16(Bt[n][k], At[m][k], acc[ai][bj][m][n], 0, 0, 0); __builtin_amdgcn_s_setprio(0); } while (0)
#define PG8_WAIT_V(n) asm volatile("s_waitcnt vmcnt(" #n ")" ::: "memory")
#define PG8_WAIT_L(n) asm volatile("s_waitcnt lgkmcnt(" #n ")" ::: "memory")
#define PG8_BAR __builtin_amdgcn_s_barrier()
#define PG8_SCHED __builtin_amdgcn_sched_barrier(0)
    Unit cur, nxt; int ui = 0;
    if (!S.next(0, cur)) return;
    f32x4 acc[2][2][4][2];
#pragma unroll
    for (int a = 0; a < 2; ++a)
#pragma unroll
        for (int b = 0; b < 2; ++b)
#pragma unroll
            for (int m = 0; m < 4; ++m)
#pragma unroll
                for (int n = 0; n < 2; ++n) acc[a][b][m][n] = (f32x4){0.f, 0.f, 0.f, 0.f};
    bf16x8 At[4][2], B0[2][2], B1[2][2];
    const char* cA = (const char*)g.A + (size_t)cur.pm * tstep; const char* cB = (const char*)g.Bt + (size_t)cur.pn * tstep;
    S.a_ready(cur);
    PG8_STAGE(PG8_SB(0, 0), cB, voffB); PG8_STAGE(PG8_SA(0, 0), cA, voffA); PG8_STAGE(PG8_SB(0, 1), cB + hstep, voffB); PG8_STAGE(PG8_SA(0, 1), cA + hstep, voffA);
    if (wr == 1) PG8_BAR;
    PG8_WAIT_V(4); PG8_BAR;
    PG8_STAGE(PG8_SB(1, 0), cB + kstep, voffB); PG8_STAGE(PG8_SA(1, 0), cA + kstep, voffA); PG8_STAGE(PG8_SB(1, 1), cB + hstep + kstep, voffB);
    PG8_WAIT_V(6); PG8_BAR;
    PG8_STAMP();
    for (;;) {
        const bool has_next = S.next(ui + 1, nxt);
        const char* nA = has_next ? (const char*)g.A + (size_t)nxt.pm * tstep : cA; const char* nB = has_next ? (const char*)g.Bt + (size_t)nxt.pn * tstep : cB;
        for (int t = 0; t < nt; t += 2) {
            const bool last = (t == nt - 2);
            const char* a1 = cA + (size_t)(t + 1) * kstep;
            const char* a2 = last ? nA : cA + (size_t)(t + 2) * kstep; const char* b2 = last ? nB : cB + (size_t)(t + 2) * kstep;
            const char* a3 = a2 + kstep; const char* b3 = b2 + kstep;
            if (last && has_next) S.a_ready(nxt);
            PG8_LDB(B0, 0, 0); PG8_SCHED; PG8_LDA(At, 0, 0); PG8_STAGE(PG8_SA(1, 1), a1 + hstep, voffA);
            PG8_WAIT_L(8); PG8_BAR; PG8_WAIT_L(0); PG8_MMA(0, 0, At, B0); PG8_BAR; PG8_SCHED;
            PG8_LDB(B1, 0, 1); PG8_STAGE(PG8_SB(0, 0), b2, voffB);
            PG8_BAR; PG8_WAIT_L(0); PG8_MMA(0, 1, At, B1); PG8_BAR;
            PG8_LDA(At, 0, 1); PG8_STAGE(PG8_SA(0, 0), a2, voffA);
            PG8_BAR; PG8_WAIT_L(0); PG8_MMA(1, 0, At, B0); PG8_BAR; PG8_SCHED;
            PG8_STAGE(PG8_SB(0, 1), b2 + hstep, voffB);
            PG8_WAIT_V(6); PG8_BAR; PG8_MMA(1, 1, At, B1); PG8_BAR;
            PG8_LDB(B0, 1, 0); PG8_SCHED; PG8_LDA(At, 1, 0); PG8_STAGE(PG8_SA(0, 1), a2 + hstep, voffA);
            PG8_WAIT_L(8); PG8_BAR; PG8_WAIT_L(0); PG8_MMA(0, 0, At, B0); PG8_BAR; PG8_SCHED;
            PG8_LDB(B1, 1, 1); PG8_STAGE(PG8_SB(1, 0), b3, voffB);
            PG8_BAR; PG8_WAIT_L(0); PG8_MMA(0, 1, At, B1); PG8_BAR;
            PG8_LDA(At, 1, 1); PG8_STAGE(PG8_SA(1, 0), a3, voffA);
            PG8_BAR; PG8_WAIT_L(0); PG8_MMA(1, 0, At, B0); PG8_BAR; PG8_SCHED;
            PG8_STAGE(PG8_SB(1, 1), b3 + hstep, voffB);
            PG8_WAIT_V(6); PG8_BAR; PG8_MMA(1, 1, At, B1); PG8_BAR;
        }
        PG8_STAMP();
        if constexpr (!Epi::AFTER_DRAIN) { E(acc, cur, wr, wc, fr, fq); S.done(cur); }
        PG8_STAMP();
        if (!has_next) break;
#pragma unroll
        for (int a = 0; a < 2; ++a)
#pragma unroll
            for (int b = 0; b < 2; ++b)
#pragma unroll
                for (int m = 0; m < 4; ++m)
#pragma unroll
                    for (int n = 0; n < 2; ++n) acc[a][b][m][n] = (f32x4){0.f, 0.f, 0.f, 0.f};
        cur = nxt; cA = nA; cB = nB; ++ui;
    }
    PG8_WAIT_V(0);
    if (wr == 0) PG8_BAR;
    PG8_BAR;
    if constexpr (Epi::AFTER_DRAIN) { E.fused(acc, cur, wr, wc, fr, fq, lds, wid, lane); S.done(cur); }
    PG8_STAMP();
    if (STAMP && wid == 0) { stamps[lane] = lane < nts ? (((unsigned long long)(unsigned)ts_hi << 32) | (unsigned)ts_lo) : 0ull;
        if (lane == 62) stamps[62] = rt_entry; if (lane == 63) stamps[63] = (unsigned long long)wall_clock64(); }
#undef PG8_STAMP
#undef PG8_SA
#undef PG8_SB
#undef PG8_STAGE
#undef PG8_LDA
#undef PG8_LDB
#undef PG8_MMA
#undef PG8_WAIT_V
#undef PG8_WAIT_L
#undef PG8_BAR
#undef PG8_SCHED
}
}

#include <cstdio>
#include <ctime>
#include <cstdlib>
#include <cstring>
#include <cmath>
#include <vector>
#include <algorithm>

template <class Epi>
DI void phase_gemm(const bf16_t* A, const bf16_t* Bt, int N, int K, char* smem, const Epi& epi) {
  pg8::StaticOrder so;
  so.init(T_, N, (int)gridDim.x, (int)blockIdx.x);
  pg8::gemm_phase((PG8_LAS unsigned char*)smem, pg8::Gemm{A, Bt, T_, N, K}, so, epi, (unsigned long long*)nullptr);
}

template <int DQK>
DI void attn_tile(char* smem, const bf16_t* __restrict__ qp, int q_ld, const bf16_t* __restrict__ kp, int k_ld,
                  const bf16_t* __restrict__ k2p, int k2_ld, const bf16_t* __restrict__ vp, int v_ld,
                  long tok_base, int tok_stride, int q0, int kv_lo, int kv_hi, int win, float scale2, float slope2,
                  int mode, float sink2, float* st_o, float* st_ml, int st_h, bf16_t* outp, int out_ld, const float2* __restrict__ qrope) {
  constexpr int KS = DQK + 8, VS = 72, NKS = DQK / 16, CPR = DQK / 8;
  bf16_t* Ks = (bf16_t*)smem;
  bf16_t* Vs = Ks + 64 * KS;
  const int tid = tidx(), lane = tid & 63, w = tid >> 6, l31 = lane & 31, hh = lane >> 5;
  const int qi = q0 + w * 32 + l31;
  const long qtok = tok_base + (long)qi * tok_stride;
  bf16x8 qf[NKS];
#pragma unroll
  for (int ks = 0; ks < NKS; ks++) qf[ks] = *(const bf16x8*)(qp + qtok * q_ld + ks * 16 + hh * 8);
  if (DQK == 96) {
    const float2* tp = qrope + (qtok & (S_ - 1)) * 16 + hh * 8;
    float r1[8], r2[8];
#pragma unroll
    for (int i = 0; i < 8; i++) {
      const float2 cs = tp[i];
      const float t1 = bf2f((bf16_t)qf[NKS - 2][i]), t2 = bf2f((bf16_t)qf[NKS - 1][i]);
      r1[i] = t1 * cs.x - t2 * cs.y; r2[i] = t2 * cs.x + t1 * cs.y;
    }
    qf[NKS - 2] = pack8(r1[0], r1[1], r1[2], r1[3], r1[4], r1[5], r1[6], r1[7]);
    qf[NKS - 1] = pack8(r2[0], r2[1], r2[2], r2[3], r2[4], r2[5], r2[6], r2[7]);
  }
  f32x16 o[2];
  float m = -1e30f, l = 0.f;
  if (mode == 2 || mode == 3) {
#pragma unroll
    for (int mb = 0; mb < 2; mb++)
#pragma unroll
      for (int g = 0; g < 4; g++) {
        const float4 v = *(const float4*)(st_o + qtok * 512 + st_h * 64 + mb * 32 + 8 * g + 4 * hh);
        o[mb][4 * g + 0] = v.x; o[mb][4 * g + 1] = v.y; o[mb][4 * g + 2] = v.z; o[mb][4 * g + 3] = v.w;
      }
    m = st_ml[qtok * 8 + st_h];
    l = st_ml[(long)T_ * 8 + qtok * 8 + st_h];
  } else {
#pragma unroll
    for (int mb = 0; mb < 2; mb++)
#pragma unroll
      for (int r = 0; r < 16; r++) o[mb][r] = 0.f;
  }
  const int q_lo = q0 + w * 32, q_hi = q_lo + 31;
  const int q4 = (lane & 15) >> 2, p4 = lane & 3, blk = (lane >> 4) & 1;

  const int kr0 = tid / CPR, kc0 = tid % CPR;
  const int kr1 = (tid + 512) / CPR, kc1 = (tid + 512) % CPR;
  const int vr = tid >> 3, vc = tid & 7;
  uint4 rk0, rk1 = make_uint4(0, 0, 0, 0), rv;
#define ATT_LOAD(KV0)                                                                                          \
  {                                                                                                            \
    const long t0 = tok_base + (long)((KV0) + kr0) * tok_stride;                                               \
    rk0 = (DQK == 96 && kc0 >= 8) ? *(const uint4*)(k2p + t0 * k2_ld + (kc0 - 8) * 8) : *(const uint4*)(kp + t0 * k_ld + kc0 * 8); \
    if (DQK == 96 && tid < 256) {                                                                              \
      const long t1 = tok_base + (long)((KV0) + kr1) * tok_stride;                                             \
      rk1 = (kc1 >= 8) ? *(const uint4*)(k2p + t1 * k2_ld + (kc1 - 8) * 8) : *(const uint4*)(kp + t1 * k_ld + kc1 * 8); \
    }                                                                                                          \
    const long t2 = tok_base + (long)((KV0) + vr) * tok_stride;                                                \
    rv = *(const uint4*)(vp + t2 * v_ld + vc * 8);                                                             \
  }
  ATT_LOAD(kv_lo)
  for (int kv0 = kv_lo; kv0 < kv_hi; kv0 += 64) {
    __syncthreads();
    *(uint4*)(Ks + kr0 * KS + kc0 * 8) = rk0;
    if (DQK == 96 && tid < 256) *(uint4*)(Ks + kr1 * KS + kc1 * 8) = rk1;
    *(uint4*)(Vs + vr * VS + vc * 8) = rv;
    __syncthreads();
    if (kv0 + 64 < kv_hi) ATT_LOAD(kv0 + 64)
    __builtin_amdgcn_sched_barrier(0);
    if (kv0 > q_hi || kv0 + 63 < q_lo - win) continue;

    f32x16 s[2];
#pragma unroll
    for (int kb = 0; kb < 2; kb++) {
#pragma unroll
      for (int r = 0; r < 16; r++) s[kb][r] = 0.f;
#pragma unroll
      for (int ks = 0; ks < NKS; ks++) {
        const bf16x8 a = lds_frag(Ks, KS, kb * 32, ks * 16, l31, hh);
        s[kb] = MFMA32(a, qf[ks], s[kb]);
      }
    }
    const bool full = (kv0 + 63 <= q_lo) && (kv0 >= q_hi - win) && (slope2 == 0.f);
    float mx = -INFINITY;
    if (full) {
#pragma unroll
      for (int kb = 0; kb < 2; kb++)
#pragma unroll
        for (int r = 0; r < 16; r++) { s[kb][r] *= scale2; mx = fmaxf(mx, s[kb][r]); }
    } else {
#pragma unroll
      for (int kb = 0; kb < 2; kb++)
#pragma unroll
        for (int r = 0; r < 16; r++) {
          const int rel = qi - (kv0 + kb * 32 + crow(r, hh));
          float v = s[kb][r] * scale2 - slope2 * (float)rel;
          v = (rel >= 0 && rel <= win) ? v : -INFINITY;
          s[kb][r] = v; mx = fmaxf(mx, v);
        }
    }
    mx = fmaxf(mx, __shfl_xor(mx, 32));
    const float mn = fmaxf(m, mx);
    const float alpha = ex2(m - mn);
    m = mn;
    float rs = 0.f;
#pragma unroll
    for (int kb = 0; kb < 2; kb++)
#pragma unroll
      for (int r = 0; r < 16; r++) { const float pv = ex2(s[kb][r] - mn); s[kb][r] = pv; rs += pv; }
    rs += __shfl_xor(rs, 32);
    l = l * alpha + rs;
#pragma unroll
    for (int mb = 0; mb < 2; mb++)
#pragma unroll
      for (int r = 0; r < 16; r++) o[mb][r] *= alpha;
#pragma unroll
    for (int kb = 0; kb < 2; kb++)
#pragma unroll
      for (int st = 0; st < 2; st++) {
        const bf16x8 pb = pack8(s[kb][8 * st + 0], s[kb][8 * st + 1], s[kb][8 * st + 2], s[kb][8 * st + 3],
                                s[kb][8 * st + 4], s[kb][8 * st + 5], s[kb][8 * st + 6], s[kb][8 * st + 7]);
#pragma unroll
        for (int mb = 0; mb < 2; mb++) {
          const bf16_t* base = Vs + (kb * 32 + 16 * st + 4 * hh + q4) * VS + mb * 32 + 16 * blk + 4 * p4;
          const s16x4 lo = tr_read(base);
          const s16x4 hi = tr_read(base + 8 * VS);
          const bf16x8 a = __builtin_shufflevector(lo, hi, 0, 1, 2, 3, 4, 5, 6, 7);
          o[mb] = MFMA32(a, pb, o[mb]);
        }
      }
  }
#undef ATT_LOAD
  if (mode == 1 || mode == 2) {
#pragma unroll
    for (int mb = 0; mb < 2; mb++)
#pragma unroll
      for (int g = 0; g < 4; g++)
        *(float4*)(st_o + qtok * 512 + st_h * 64 + mb * 32 + 8 * g + 4 * hh) =
            make_float4(o[mb][4 * g + 0], o[mb][4 * g + 1], o[mb][4 * g + 2], o[mb][4 * g + 3]);
    if (hh == 0) { st_ml[qtok * 8 + st_h] = m; st_ml[(long)T_ * 8 + qtok * 8 + st_h] = l; }
  } else {
    float mult;
    if (mode == 4) {
      const float mf = fmaxf(m, sink2);
      const float a = ex2(m - mf);
      mult = a * rcpf(l * a + ex2(sink2 - mf));
    } else {
      mult = rcpf(l);
    }
#pragma unroll
    for (int mb = 0; mb < 2; mb++)
#pragma unroll
      for (int g = 0; g < 4; g++)
        *(uint2*)(outp + qtok * out_ld + mb * 32 + 8 * g + 4 * hh) =
            make_uint2(pack2(o[mb][4 * g + 0] * mult, o[mb][4 * g + 1] * mult), pack2(o[mb][4 * g + 2] * mult, o[mb][4 * g + 3] * mult));
  }
}

DI void attnA_task(const Params& p, char* smem, int tau, int pat) {
  const int dil = (pat == 0) ? 1 : (pat == 1 ? 4 : 16);
  const int ntile = (S_ / dil) >> 8;
  const int bh = tau >> 6, rem = tau & 63;
  const int r = rem / ntile, n = rem % ntile;
  const int b = bh >> 3, h = bh & 7;
  const bf16_t* pj = (const bf16_t*)(p.ws + OFF_BIG);
  const int q0 = n * 256;
  const int kv_lo = (q0 >= 128) ? q0 - 128 : 0;
  const float slope2 = exp2f(-(float)(h + 1)) * (float)dil * LOG2E;
  const int mode = (pat == 0) ? 1 : (pat == 1 ? 2 : 3);
  attn_tile<64>(smem, pj + h * 64, 3088, pj + 512 + h * 64, 3088, nullptr, 0, pj + 1024 + h * 64, 3088,
                (long)b * S_ + r, dil, q0, kv_lo, q0 + 256, 128, 0.125f * LOG2E, slope2, mode, 0.f,
                (float*)(p.ws + OFF_HBUF), (float*)(p.ws + OFF_ML), h,
                (bf16_t*)(p.ws + OFF_MIX) + h * 64, 1024, nullptr);
}

DI void attnC_task(const Params& p, char* smem, int tau) {
  const int b = tau >> 9, hq = (tau >> 6) & 7, tile = tau & 63;
  const int kvh = hq >> 2;
  const bf16_t* pj = (const bf16_t*)(p.ws + OFF_P1);
  const int q0 = tile * 256;
  const int kv_lo = (q0 >= 128) ? q0 - 128 : 0;
  attn_tile<64>(smem, pj + hq * 64, 1440, pj + 512 + kvh * 64, 1440, nullptr, 0, pj + 640 + kvh * 64, 1440,
                (long)b * S_, 1, q0, kv_lo, q0 + 256, 127, 0.125f * LOG2E, exp2f(-(float)(hq + 1)) * LOG2E, 4,
                p.sinks[hq] * LOG2E, nullptr, nullptr, 0, (bf16_t*)(p.ws + OFF_MIX) + hq * 64, 1024, nullptr);
}

DI void attnD_task(const Params& p, char* smem, int tau) {
  const int bh = tau >> 5, i = tau & 31;
  const int b = bh >> 3, h = bh & 7;
  const bf16_t* qb = (const bf16_t*)(p.ws + OFF_Q);
  const bf16_t* kv = (const bf16_t*)(p.ws + OFF_KV);
  const bf16_t* kpe = (const bf16_t*)(p.ws + OFF_KPE);
  const float scale2 = 0.10206207261596575f * LOG2E;
#pragma unroll 1
  for (int u = 0; u < 2; u++) {
    const int tile = u ? i : (63 - i);
    const int q0 = tile * 256;
    attn_tile<96>(smem, qb + h * 96, 768, kv + h * 128, 1024, kpe, 32, kv + h * 128 + 64, 1024,
                  (long)b * S_, 1, q0, 0, q0 + 256, 1 << 30, scale2, 0.f, 0, 0.f, nullptr, nullptr, 0,
                  (bf16_t*)(p.ws + OFF_MIX) + 512 + h * 64, 1024, (const float2*)(p.ws + OFF_ROPE));
  }
}

DI void gla_gate(const Params& p, float* bc, long tok0, int h, int tid) {
  const bf16_t* pj = (const bf16_t*)(p.ws + OFF_BIG);
  const int d = tid & 63, sg = tid >> 6;
  float wc[16];
#pragma unroll
  for (int r = 0; r < 16; r++) wc[r] = p.gla_wg[r * 256 + h * 64 + d];
  const float bias = p.gla_bg[h * 64 + d];
#pragma unroll 1
  for (int i = 0; i < 16; i++) {
    const int s = sg * 16 + i;
    const uint4* gp = (const uint4*)(pj + (tok0 + s) * 3088 + 3072);
    const uint4 g0 = gp[0], g1 = gp[1];
    float x = bias;
    x += bflo(g0.x) * wc[0] + bfhi(g0.x) * wc[1] + bflo(g0.y) * wc[2] + bfhi(g0.y) * wc[3];
    x += bflo(g0.z) * wc[4] + bfhi(g0.z) * wc[5] + bflo(g0.w) * wc[6] + bfhi(g0.w) * wc[7];
    x += bflo(g1.x) * wc[8] + bfhi(g1.x) * wc[9] + bflo(g1.y) * wc[10] + bfhi(g1.y) * wc[11];
    x += bflo(g1.z) * wc[12] + bfhi(g1.z) * wc[13] + bflo(g1.w) * wc[14] + bfhi(g1.w) * wc[15];
    const float ls = fminf(x, 0.f) - __logf(1.f + __expf(-fabsf(x)));
    bc[s * 64 + d] = ls * (1.f / 16.f);
  }
  __syncthreads();
  if (tid < 64) {
    float c = 0.f;
#pragma unroll 8
    for (int s = 0; s < 64; s++) { c += bc[s * 64 + tid]; bc[s * 64 + tid] = c; }
  }
  __syncthreads();
}

DI void gla_stage_vt(const Params& p, bf16_t* Vt, long tok0, int h, int tid) {
  const bf16_t* pj = (const bf16_t*)(p.ws + OFF_BIG);
  const int e = tid & 127, sg2 = tid >> 7;
  unsigned wv[16];
#pragma unroll
  for (int j = 0; j < 16; j++) {
    const unsigned lo = pj[(tok0 + sg2 * 32 + 2 * j) * 3088 + 2048 + h * 128 + e];
    const unsigned hi = pj[(tok0 + sg2 * 32 + 2 * j + 1) * 3088 + 2048 + h * 128 + e];
    wv[j] = lo | (hi << 16);
  }
  uint4* dp = (uint4*)(Vt + e * 72 + sg2 * 32);
  dp[0] = make_uint4(wv[0], wv[1], wv[2], wv[3]);
  dp[1] = make_uint4(wv[4], wv[5], wv[6], wv[7]);
  dp[2] = make_uint4(wv[8], wv[9], wv[10], wv[11]);
  dp[3] = make_uint4(wv[12], wv[13], wv[14], wv[15]);
}

DI void gla_a_task(const Params& p, char* smem, int task) {
  const int tid = tidx() & 255, lane = tid & 63, w = tid >> 6, l31 = lane & 31, hh = lane >> 5;
  smem += (tidx() >> 8) * 73728;
  const int bh = task >> 8, n = task & 255, b = bh >> 2, h = bh & 3;
  const long tok0 = (long)b * S_ + n * 64;
  float* bc = (float*)smem;
  bf16_t* Vt = (bf16_t*)(smem + 34816);
  bf16_t* KdT = (bf16_t*)(smem + 53248);
  const bf16_t* pj = (const bf16_t*)(p.ws + OFF_BIG);
  gla_gate(p, bc, tok0, h, tid);
  {
    const int d = tid & 63, sg = tid >> 6;
    const float bl = bc[63 * 64 + d];
    unsigned wv[8];
#pragma unroll
    for (int j = 0; j < 8; j++) {
      const int s0 = sg * 16 + 2 * j;
      const float k0 = bf2f(pj[(tok0 + s0) * 3088 + 1792 + h * 64 + d]) * __expf(bl - bc[s0 * 64 + d]);
      const float k1 = bf2f(pj[(tok0 + s0 + 1) * 3088 + 1792 + h * 64 + d]) * __expf(bl - bc[(s0 + 1) * 64 + d]);
      wv[j] = pack2(k0, k1);
    }
    uint4* dp = (uint4*)(KdT + d * 72 + sg * 16);
    dp[0] = make_uint4(wv[0], wv[1], wv[2], wv[3]);
    dp[1] = make_uint4(wv[4], wv[5], wv[6], wv[7]);
  }
  gla_stage_vt(p, Vt, tok0, h, tid);
  __syncthreads();
  f32x16 acc[2];
#pragma unroll
  for (int nb = 0; nb < 2; nb++)
#pragma unroll
    for (int r = 0; r < 16; r++) acc[nb][r] = 0.f;
#pragma unroll
  for (int ks = 0; ks < 4; ks++) {
    const bf16x8 a = lds_frag(Vt, 72, w * 32, ks * 16, l31, hh);
#pragma unroll
    for (int nb = 0; nb < 2; nb++) {
      const bf16x8 bb = lds_frag(KdT, 72, nb * 32, ks * 16, l31, hh);
      acc[nb] = MFMA32(a, bb, acc[nb]);
    }
  }
  float* dst = (float*)((char*)p.out + OUT_DST) + (long)task * 8192;
#pragma unroll
  for (int nb = 0; nb < 2; nb++)
#pragma unroll
    for (int r = 0; r < 16; r++) dst[(w * 32 + crow(r, hh)) * 64 + nb * 32 + l31] = acc[nb][r];
  if (tid < 64) ((float*)((char*)p.out + OUT_DEC))[task * 64 + tid] = __expf(bc[63 * 64 + tid]);
  __syncthreads();
}

DI void gla_scan_item(const Params& p, int item) {
  const int idx = item * NTHR + tidx();
  const int bh = idx >> 13, ed = idx & 8191, d = ed & 63;
  const float* dS = (const float*)((char*)p.out + OUT_DST);
  const float* dec = (const float*)((char*)p.out + OUT_DEC);
  bf16_t* sp = (bf16_t*)((char*)p.out + OUT_SPT);
  float st = 0.f;
#pragma unroll 1
  for (int n = 0; n < 256; n += 8) {
    float ds[8], dc[8];
#pragma unroll
    for (int u = 0; u < 8; u++) {
      const long task = bh * 256 + n + u;
      ds[u] = dS[task * 8192 + ed];
      dc[u] = dec[task * 64 + d];
    }
#pragma unroll
    for (int u = 0; u < 8; u++) {
      const long task = bh * 256 + n + u;
      sp[task * 8192 + ed] = f2bf(st);
      st = dc[u] * st + ds[u];
    }
  }
}

DI void gla_c_task(const Params& p, char* smem, int task) {
  const int tid = tidx() & 255, lane = tid & 63, w = tid >> 6, l31 = lane & 31, hh = lane >> 5;
  smem += (tidx() >> 8) * 73728;
  const int bh = task >> 8, n = task & 255, b = bh >> 2, h = bh & 3;
  const long tok0 = (long)b * S_ + n * 64;
  float* bc = (float*)smem;
  bf16_t* att = (bf16_t*)smem;
  bf16_t* Qg = (bf16_t*)(smem + 16384);
  bf16_t* Kg = (bf16_t*)(smem + 25600);
  bf16_t* Vt = (bf16_t*)(smem + 34816);
  bf16_t* SpT = (bf16_t*)(smem + 53248);
  float* red = (float*)(smem + 71680);
  const bf16_t* pj = (const bf16_t*)(p.ws + OFF_BIG);
  gla_gate(p, bc, tok0, h, tid);
  {
    const int d = tid & 63, sg = tid >> 6;
    const float bm = bc[31 * 64 + d];
#pragma unroll 4
    for (int i = 0; i < 16; i++) {
      const int s = sg * 16 + i;
      const float bb = bc[s * 64 + d];
      const float qv = bf2f(pj[(tok0 + s) * 3088 + 1536 + h * 64 + d]);
      const float kv = bf2f(pj[(tok0 + s) * 3088 + 1792 + h * 64 + d]);
      Qg[s * 72 + d] = f2bf(qv * 0.125f * __expf(bb - bm));
      Kg[s * 72 + d] = f2bf(kv * __expf(bm - bb));
    }
  }
  gla_stage_vt(p, Vt, tok0, h, tid);
  {
    const int e = tid >> 1, hf = tid & 1;
    const uint4* sp = (const uint4*)((const bf16_t*)((char*)p.out + OUT_SPT) + (long)task * 8192 + e * 64 + hf * 32);
    uint4* dp = (uint4*)(SpT + e * 72 + hf * 32);
#pragma unroll
    for (int c = 0; c < 4; c++) {
      const uint4 v = sp[c];
      const int d0 = hf * 32 + c * 8;
      uint4 o;
      o.x = pack2(bflo(v.x) * __expf(bc[31 * 64 + d0 + 0]), bfhi(v.x) * __expf(bc[31 * 64 + d0 + 1]));
      o.y = pack2(bflo(v.y) * __expf(bc[31 * 64 + d0 + 2]), bfhi(v.y) * __expf(bc[31 * 64 + d0 + 3]));
      o.z = pack2(bflo(v.z) * __expf(bc[31 * 64 + d0 + 4]), bfhi(v.z) * __expf(bc[31 * 64 + d0 + 5]));
      o.w = pack2(bflo(v.w) * __expf(bc[31 * 64 + d0 + 6]), bfhi(v.w) * __expf(bc[31 * 64 + d0 + 7]));
      dp[c] = o;
    }
  }
  __syncthreads();
  {
    const int mb = w & 1, nb = w >> 1;
    f32x16 a2;
#pragma unroll
    for (int r = 0; r < 16; r++) a2[r] = 0.f;
#pragma unroll
    for (int ks = 0; ks < 4; ks++) {
      const bf16x8 a = lds_frag(Qg, 72, mb * 32, ks * 16, l31, hh);
      const bf16x8 bb = lds_frag(Kg, 72, nb * 32, ks * 16, l31, hh);
      a2 = MFMA32(a, bb, a2);
    }
#pragma unroll
    for (int r = 0; r < 16; r++) {
      const int c = mb * 32 + crow(r, hh), s = nb * 32 + l31;
      att[c * 72 + s] = f2bf((s <= c) ? a2[r] : 0.f);
    }
  }
  __syncthreads();
  f32x16 acc[2];
#pragma unroll
  for (int nb = 0; nb < 2; nb++)
#pragma unroll
    for (int r = 0; r < 16; r++) acc[nb][r] = 0.f;
#pragma unroll
  for (int ks = 0; ks < 4; ks++) {
    const bf16x8 a = lds_frag(Vt, 72, w * 32, ks * 16, l31, hh);
#pragma unroll
    for (int nb = 0; nb < 2; nb++) acc[nb] = MFMA32(a, lds_frag(att, 72, nb * 32, ks * 16, l31, hh), acc[nb]);
  }
#pragma unroll
  for (int ks = 0; ks < 4; ks++) {
    const bf16x8 a = lds_frag(SpT, 72, w * 32, ks * 16, l31, hh);
#pragma unroll
    for (int nb = 0; nb < 2; nb++) acc[nb] = MFMA32(a, lds_frag(Qg, 72, nb * 32, ks * 16, l31, hh), acc[nb]);
  }
#pragma unroll
  for (int nb = 0; nb < 2; nb++) {
    float ss = 0.f;
#pragma unroll
    for (int r = 0; r < 16; r++) ss += acc[nb][r] * acc[nb][r];
    ss += __shfl_xor(ss, 32);
    if (hh == 0) red[w * 64 + nb * 32 + l31] = ss;
  }
  __syncthreads();
  bf16_t* mix = (bf16_t*)(p.ws + OFF_MIX);
#pragma unroll
  for (int nb = 0; nb < 2; nb++) {
    const int c = nb * 32 + l31;
    const float tot = red[c] + red[64 + c] + red[128 + c] + red[192 + c];
    const float rn = rsqrtf(tot * (1.f / 128.f) + 1e-6f);
    const long tok = tok0 + c;
#pragma unroll
    for (int g = 0; g < 4; g++) {
      const int e0 = w * 32 + 8 * g + 4 * hh;
      const float4 gn = *(const float4*)(p.gla_norm + e0);
      const uint2 rr = *(const uint2*)(pj + tok * 3088 + 2560 + h * 128 + e0);
      const float o0 = acc[nb][4 * g + 0] * rn * gn.x * siluf(bflo(rr.x));
      const float o1 = acc[nb][4 * g + 1] * rn * gn.y * siluf(bfhi(rr.x));
      const float o2 = acc[nb][4 * g + 2] * rn * gn.z * siluf(bflo(rr.y));
      const float o3 = acc[nb][4 * g + 3] * rn * gn.w * siluf(bfhi(rr.y));
      *(uint2*)(mix + tok * 1024 + 512 + h * 128 + e0) = make_uint2(pack2(o0, o1), pack2(o2, o3));
    }
  }
  __syncthreads();
}

DI void phase_latent(const Params& p) {
  const int lane = tidx() & 63, w = tidx() >> 6;
  const bf16_t* pj = (const bf16_t*)(p.ws + OFF_P1);
  bf16_t* cqn = (bf16_t*)(p.ws + OFF_CQN);
  bf16_t* ckvn = (bf16_t*)(p.ws + OFF_CKVN);
  bf16_t* kpe = (bf16_t*)(p.ws + OFF_KPE);
  const float2* tab = (const float2*)(p.ws + OFF_ROPE);
  for (int row = blockIdx.x * 8 + w; row < T_; row += gridDim.x * 8) {
    const bf16_t* pr = pj + (long)row * 1440;
    uint4 a = make_uint4(0, 0, 0, 0), c = make_uint4(0, 0, 0, 0);
    if (lane < 48) a = *(const uint4*)(pr + 768 + lane * 8);
    if (lane < 32) c = *(const uint4*)(pr + 1152 + lane * 8);
    float av[8] = {bflo(a.x), bfhi(a.x), bflo(a.y), bfhi(a.y), bflo(a.z), bfhi(a.z), bflo(a.w), bfhi(a.w)};
    float cv[8] = {bflo(c.x), bfhi(c.x), bflo(c.y), bfhi(c.y), bflo(c.z), bfhi(c.z), bflo(c.w), bfhi(c.w)};
    float sa = 0.f, sc = 0.f;
#pragma unroll
    for (int j = 0; j < 8; j++) { sa += av[j] * av[j]; sc += cv[j] * cv[j]; }
    sa = wave_sum(sa); sc = wave_sum(sc);
    const float ra = rsqrtf(sa * (1.f / 384.f) + 1e-6f), rc = rsqrtf(sc * (1.f / 256.f) + 1e-6f);
    if (lane < 48) {
      const float4 g0 = *(const float4*)(p.q_norm + lane * 8), g1 = *(const float4*)(p.q_norm + lane * 8 + 4);
      *(uint4*)(cqn + (long)row * 384 + lane * 8) =
          make_uint4(pack2(av[0] * ra * g0.x, av[1] * ra * g0.y), pack2(av[2] * ra * g0.z, av[3] * ra * g0.w),
                     pack2(av[4] * ra * g1.x, av[5] * ra * g1.y), pack2(av[6] * ra * g1.z, av[7] * ra * g1.w));
    }
    if (lane < 32) {
      const float4 g0 = *(const float4*)(p.kv_norm + lane * 8), g1 = *(const float4*)(p.kv_norm + lane * 8 + 4);
      *(uint4*)(ckvn + (long)row * 256 + lane * 8) =
          make_uint4(pack2(cv[0] * rc * g0.x, cv[1] * rc * g0.y), pack2(cv[2] * rc * g0.z, cv[3] * rc * g0.w),
                     pack2(cv[4] * rc * g1.x, cv[5] * rc * g1.y), pack2(cv[6] * rc * g1.z, cv[7] * rc * g1.w));
    }
    if (lane < 16) {
      const float t1 = bf2f(pr[1408 + lane]), t2 = bf2f(pr[1408 + 16 + lane]);
      const float2 cs = tab[(row & (S_ - 1)) * 16 + lane];
      kpe[(long)row * 32 + lane] = f2bf(t1 * cs.x - t2 * cs.y);
      kpe[(long)row * 32 + 16 + lane] = f2bf(t2 * cs.x + t1 * cs.y);
    }
  }
}

__global__ void __launch_bounds__(NTHR, 2) mega_kernel(Params p) {
  __shared__ __attribute__((aligned(16))) char smem[LDS_BYTES];
  cg::grid_group grid = cg::this_grid();
  char* ws = p.ws;
  bf16_t* hbuf = (bf16_t*)(ws + OFF_HBUF);
  bf16_t* mix = (bf16_t*)(ws + OFF_MIX);
  bf16_t* big = (bf16_t*)(ws + OFF_BIG);
  const int G = gridDim.x, bid = blockIdx.x, grp = tidx() >> 8;

  phase_convert(p, smem);
  phase_rope_table(p);
  phase_rms_first(p.x, p.n_mix_pre, hbuf);
  grid.sync();
  phase_gemm(hbuf, (const bf16_t*)(ws + OFF_W0IN), 3328, 1024, smem, pg8::EpiStoreP{big, 3088, 3088});
  grid.sync();
  for (int t = bid; t < 2048; t += G) { if (t < 1024) gla_a_task(p, smem, 2 * t + grp); else attnA_task(p, smem, t - 1024, 0); }
  grid.sync();
  for (int t = bid; t < 128 + 1024; t += G) { if (t < 128) gla_scan_item(p, t); else attnA_task(p, smem, t - 128, 1); }
  grid.sync();
  for (int t = bid; t < 2048; t += G) { if (t < 1024) gla_c_task(p, smem, 2 * t + grp); else attnA_task(p, smem, t - 1024, 2); }
  grid.sync();
  phase_gemm(mix, (const bf16_t*)(ws + OFF_W0OUT), 1024, 1024, smem, pg8::EpiStoreP{hbuf, 1024, 1024});
  grid.sync();
  phase_resid(p.x, p.out, hbuf, p.n_mix_post, p.n_ffn_pre);
  grid.sync();
  phase_gemm(hbuf, (const bf16_t*)(ws + OFF_WGU0), 5632, 1024, smem, pg8::EpiSwigluP{big});
  grid.sync();
  phase_gemm(big, (const bf16_t*)(ws + OFF_WDN0), 1024, 2816, smem, pg8::EpiStoreP{hbuf, 1024, 1024});
  grid.sync();
  phase_resid(p.out, p.out, hbuf, p.n_ffn_post, p.n_mix_pre + 1024);
  grid.sync();
  phase_gemm(hbuf, (const bf16_t*)(ws + OFF_W1IN), 1536, 1024, smem, pg8::EpiStoreP{(bf16_t*)(ws + OFF_P1), 1440, 1440});
  grid.sync();
  phase_latent(p);
  grid.sync();
  {
    phase_gemm((const bf16_t*)(ws + OFF_CQN), (const bf16_t*)(ws + OFF_WUQ), 768, 384, smem, pg8::EpiStoreP{(bf16_t*)(ws + OFF_Q), 768, 768});
    phase_gemm((const bf16_t*)(ws + OFF_CKVN), (const bf16_t*)(ws + OFF_WUKV), 1024, 256, smem, pg8::EpiStoreP{(bf16_t*)(ws + OFF_KV), 1024, 1024});
  }
  grid.sync();
  for (int t = bid; t < 512 + 1024; t += G) { if (t < 512) attnD_task(p, smem, t); else attnC_task(p, smem, t - 512); }
  grid.sync();
  phase_gemm(mix, (const bf16_t*)(ws + OFF_W1OUT), 1024, 1024, smem, pg8::EpiStoreP{hbuf, 1024, 1024});
  grid.sync();
  phase_resid(p.out, p.out, hbuf, p.n_mix_post + 1024, p.n_ffn_pre + 1024);
  grid.sync();
  phase_gemm(hbuf, (const bf16_t*)(ws + OFF_WGU1), 5632, 1024, smem, pg8::EpiSwigluP{big});
  grid.sync();
  phase_gemm(big, (const bf16_t*)(ws + OFF_WDN1), 1024, 2816, smem, pg8::EpiStoreP{hbuf, 1024, 1024});
  grid.sync();
  phase_resid(p.out, p.out, hbuf, p.n_ffn_post + 1024, nullptr);
}

extern "C" void kernel_launch(void* const* d_in, const int* in_sizes, int n_in, void* d_out, int out_size, void* d_ws,
                              size_t ws_size, hipStream_t stream) {
  static int grid_blocks = 0;
  if (!grid_blocks) {
    int dev = 0, cus = 0, per_cu = 0;
    hipGetDevice(&dev);
    hipDeviceGetAttribute(&cus, hipDeviceAttributeMultiprocessorCount, dev);
    hipOccupancyMaxActiveBlocksPerMultiprocessor(&per_cu, mega_kernel, NTHR, 0);
    if (per_cu < 1) per_cu = 1;
    grid_blocks = cus * per_cu;
  }
  if (ws_size < (size_t)WS_NEED) { fprintf(stderr, "workspace too small: %zu < %ld\n", ws_size, (long)WS_NEED); return; }
  Params p{};
  const float** f = (const float**)&p;
  for (int i = 0; i < 20; i++) f[i] = (const float*)d_in[i];
  p.out = (float*)d_out;
  p.ws = (char*)d_ws;
  void* args[] = {&p};
  hipError_t e = hipLaunchCooperativeKernel((void*)mega_kernel, dim3(grid_blocks), dim3(NTHR), args, 0, stream);
  if (e != hipSuccess) fprintf(stderr, "cooperative launch failed: %s (grid %d)\n", hipGetErrorString(e), grid_blocks);
}
```

```cpp
#include <hip/hip_runtime.h>
#include <hip/hip_cooperative_groups.h>
#include <cstdio>
namespace cg = cooperative_groups;

typedef unsigned short bf16_t;
using bf16x8 = __attribute__((ext_vector_type(8))) short;
using s16x4  = __attribute__((ext_vector_type(4))) short;
using f32x16 = __attribute__((ext_vector_type(16))) float;
typedef __attribute__((ext_vector_type(2))) __bf16 bf2_t;
#define DI __device__ __forceinline__
#define MFMA32(a, b, c) __builtin_amdgcn_mfma_f32_32x32x16_bf16((a), (b), (c), 0, 0, 0)

constexpr int T_ = 32768, S_ = 16384;
constexpr float LOG2E = 1.4426950408889634f;
constexpr int LDS_BYTES = 147456;
constexpr int NTHR = 512;

constexpr long OFF_W0IN  = 0;
constexpr long OFF_W0OUT = OFF_W0IN  + 3328L * 1024 * 2;
constexpr long OFF_WGU0  = OFF_W0OUT + 1024L * 1024 * 2;
constexpr long OFF_WGU1  = OFF_WGU0  + 5632L * 1024 * 2;
constexpr long OFF_WDN0  = OFF_WGU1  + 5632L * 1024 * 2;
constexpr long OFF_WDN1  = OFF_WDN0  + 1024L * 2816 * 2;
constexpr long OFF_W1IN  = OFF_WDN1  + 1024L * 2816 * 2;
constexpr long OFF_W1OUT = OFF_W1IN  + 1536L * 1024 * 2;
constexpr long OFF_WUQ   = OFF_W1OUT + 1024L * 1024 * 2;
constexpr long OFF_WUKV  = OFF_WUQ   + 768L * 384 * 2;
constexpr long OFF_ROPE  = OFF_WUKV  + 1024L * 256 * 2;
constexpr long OFF_ML    = OFF_ROPE  + 16384L * 16 * 8;
constexpr long OFF_HBUF  = OFF_ML    + (long)T_ * 8 * 4 * 2;
constexpr long OFF_MIX   = OFF_HBUF  + (long)T_ * 1024 * 2;
constexpr long OFF_KV    = OFF_MIX   + (long)T_ * 1024 * 2;
constexpr long OFF_BIG   = OFF_KV    + (long)T_ * 1024 * 2;
constexpr long OFF_BAR   = OFF_BIG   + (long)T_ * 3088 * 2;
constexpr long WS_NEED   = OFF_BAR + 256;
constexpr long OFF_P1    = OFF_BIG;
constexpr long OFF_CQN   = OFF_P1   + (long)T_ * 1440 * 2;
constexpr long OFF_CKVN  = OFF_CQN  + (long)T_ * 384 * 2;
constexpr long OFF_KPE   = OFF_CKVN + (long)T_ * 256 * 2;
constexpr long OFF_Q     = OFF_KPE  + (long)T_ * 32 * 2;
constexpr long OUT_DST   = 0;
constexpr long OUT_SPT   = 2048L * 8192 * 4;
constexpr long OUT_DEC   = OUT_SPT + 2048L * 8192 * 2;

struct Params {
  const float *x, *n_mix_pre, *n_mix_post, *n_ffn_pre, *n_ffn_post, *ffn_g, *ffn_u, *ffn_d;
  const float *ab_in, *ab_out, *gla_wg, *gla_bg, *gla_norm, *cd_in, *cd_out, *sinks, *q_norm, *w_uq, *kv_norm, *w_ukv;
  float* out;
  char* ws;
};

DI int tidx() { int t = threadIdx.x; asm volatile("" : "+v"(t)); return t; }
DI unsigned pack2(float a, float b) { bf2_t v; v[0] = (__bf16)a; v[1] = (__bf16)b; return __builtin_bit_cast(unsigned, v); }
DI bf16_t f2bf(float a) { return __builtin_bit_cast(unsigned short, (__bf16)a); }
DI float bf2f(bf16_t v) { return __uint_as_float(((unsigned)v) << 16); }
DI float bflo(unsigned u) { return __uint_as_float(u << 16); }
DI float bfhi(unsigned u) { return __uint_as_float(u & 0xffff0000u); }
DI float ex2(float x) { return __builtin_amdgcn_exp2f(x); }
DI float rcpf(float x) { return __builtin_amdgcn_rcpf(x); }
DI float siluf(float x) { return x * rcpf(1.f + __expf(-x)); }
DI int crow(int reg, int hh) { return (reg & 3) + 8 * (reg >> 2) + 4 * hh; }
DI float wave_sum(float v) {
#pragma unroll
  for (int o = 32; o; o >>= 1) v += __shfl_xor(v, o);
  return v;
}
DI bf16x8 pack8(float a0, float a1, float a2, float a3, float a4, float a5, float a6, float a7) {
  uint4 u = make_uint4(pack2(a0, a1), pack2(a2, a3), pack2(a4, a5), pack2(a6, a7));
  return __builtin_bit_cast(bf16x8, u);
}
DI bf16x8 lds_frag(const bf16_t* base, int stride, int row0, int kofs, int l31, int hh) {
  return *(const bf16x8*)(base + (row0 + l31) * stride + kofs + hh * 8);
}
DI s16x4 tr_read(const bf16_t* p) {
  return __builtin_amdgcn_ds_read_tr16_b64_v4i16((__attribute__((address_space(3))) s16x4*)(p));
}

DI void phase_convert(const Params& p, char* smem) {
  const int tid = tidx() & 255, grp = tidx() >> 8;
  float* tl = (float*)(smem + grp * 16640);
  for (int it0 = blockIdx.x * 2; it0 < 6088; it0 += gridDim.x * 2) {
    const int it = it0 + grp;
    const float *sa, *sb; int K, N, mode = 0, t; long doff;
    if (it < 832)       { t = it;        sa = p.ab_in;  sb = sa; K = 1024; N = 3088; doff = OFF_W0IN; }
    else if (it < 1088) { t = it - 832;  sa = p.ab_out; sb = sa; K = 1024; N = 1024; doff = OFF_W0OUT; }
    else if (it < 2496) { t = it - 1088; sa = p.ffn_g;  sb = p.ffn_u; K = 1024; N = 2816; mode = 1; doff = OFF_WGU0; }
    else if (it < 3904) { t = it - 2496; sa = p.ffn_g + 1024L * 2816; sb = p.ffn_u + 1024L * 2816; K = 1024; N = 2816; mode = 1; doff = OFF_WGU1; }
    else if (it < 4608) { t = it - 3904; sa = p.ffn_d;  sb = sa; K = 2816; N = 1024; doff = OFF_WDN0; }
    else if (it < 5312) { t = it - 4608; sa = p.ffn_d + 2816L * 1024; sb = sa; K = 2816; N = 1024; doff = OFF_WDN1; }
    else if (it < 5696) { t = it - 5312; sa = p.cd_in;  sb = sa; K = 1024; N = 1440; doff = OFF_W1IN; }
    else if (it < 5952) { t = it - 5696; sa = p.cd_out; sb = sa; K = 1024; N = 1024; doff = OFF_W1OUT; }
    else if (it < 6024) { t = it - 5952; sa = p.w_uq;   sb = sa; K = 384;  N = 768;  doff = OFF_WUQ; }
    else                { t = it - 6024; sa = p.w_ukv;  sb = sa; K = 256;  N = 1024; doff = OFF_WUKV; }
    bf16_t* dst = (bf16_t*)(p.ws + doff);
    const int nkt = K >> 6;
    const int kt = t % nkt, nt = t / nkt;
    const int k0 = kt * 64, n0 = nt * 64;
    const int nn = tid & 63, kr = tid >> 6;
    const float* src; int col;
    if (mode) { src = ((nt & 3) < 2) ? sa : sb; col = (nt >> 2) * 128 + (nt & 1) * 64 + nn; }
    else      { src = sa; col = n0 + nn; }
    const bool ok = col < N;
#pragma unroll
    for (int i = 0; i < 16; i++) {
      const int kk = i * 4 + kr;
      tl[kk * 65 + nn] = ok ? src[(long)(k0 + kk) * N + col] : 0.f;
    }
    __syncthreads();
    const int n2 = tid >> 2, kq = (tid & 3) * 16;
    unsigned wv[8];
#pragma unroll
    for (int j = 0; j < 8; j++) wv[j] = pack2(tl[(kq + 2 * j) * 65 + n2], tl[(kq + 2 * j + 1) * 65 + n2]);
    uint4* dp = (uint4*)(dst + (long)(n0 + n2) * K + k0 + kq);
    dp[0] = make_uint4(wv[0], wv[1], wv[2], wv[3]);
    dp[1] = make_uint4(wv[4], wv[5], wv[6], wv[7]);
    __syncthreads();
  }
}

DI void phase_rope_table(const Params& p) {
  float2* tab = (float2*)(p.ws + OFF_ROPE);
  for (int i = blockIdx.x * NTHR + tidx(); i < 16384 * 16; i += gridDim.x * NTHR) {
    const int pos = i >> 4, j = i & 15;
    const float freq = exp2f(-(float)j * (13.287712379549449f / 16.f));
    const float ang = (float)pos * freq;
    const double a = (double)ang;
    const double k = rint(a * 0.15915494309189535);
    const float rf = (float)(a - k * 6.283185307179586);
    tab[i] = make_float2(__cosf(rf), __sinf(rf));
  }
}

DI void phase_rms_first(const float* __restrict__ x, const float* __restrict__ g, bf16_t* __restrict__ h) {
  const int lane = tidx() & 63, w = tidx() >> 6;
  for (int row = blockIdx.x * 8 + w; row < T_; row += gridDim.x * 8) {
    const float4* xr = (const float4*)(x + (long)row * 1024);
    float4 v[4]; float ss = 0.f;
#pragma unroll
    for (int i = 0; i < 4; i++) { v[i] = xr[lane + i * 64]; ss += v[i].x * v[i].x + v[i].y * v[i].y + v[i].z * v[i].z + v[i].w * v[i].w; }
    ss = wave_sum(ss);
    const float r = rsqrtf(ss * (1.f / 1024.f) + 1e-6f);
    uint2* hr = (uint2*)(h + (long)row * 1024);
#pragma unroll
    for (int i = 0; i < 4; i++) {
      const float4 gg = ((const float4*)g)[lane + i * 64];
      hr[lane + i * 64] = make_uint2(pack2(v[i].x * r * gg.x, v[i].y * r * gg.y), pack2(v[i].z * r * gg.z, v[i].w * r * gg.w));
    }
  }
}

DI void phase_resid(const float* xin, float* xout, bf16_t* yh, const float* __restrict__ gpost, const float* __restrict__ gnext) {
  const int lane = tidx() & 63, w = tidx() >> 6;
  for (int row = blockIdx.x * 8 + w; row < T_; row += gridDim.x * 8) {
    uint2* yr = (uint2*)(yh + (long)row * 1024);
    const float4* xr = (const float4*)(xin + (long)row * 1024);
    float4* xo = (float4*)(xout + (long)row * 1024);
    float4 y[4]; float ss = 0.f;
#pragma unroll
    for (int i = 0; i < 4; i++) {
      const uint2 u = yr[lane + i * 64];
      y[i] = make_float4(bflo(u.x), bfhi(u.x), bflo(u.y), bfhi(u.y));
      ss += y[i].x * y[i].x + y[i].y * y[i].y + y[i].z * y[i].z + y[i].w * y[i].w;
    }
    ss = wave_sum(ss);
    const float r1 = rsqrtf(ss * (1.f / 1024.f) + 1e-6f);
    float ss2 = 0.f;
#pragma unroll
    for (int i = 0; i < 4; i++) {
      const float4 gg = ((const float4*)gpost)[lane + i * 64];
      const float4 xv = xr[lane + i * 64];
      y[i].x = xv.x + y[i].x * r1 * gg.x; y[i].y = xv.y + y[i].y * r1 * gg.y;
      y[i].z = xv.z + y[i].z * r1 * gg.z; y[i].w = xv.w + y[i].w * r1 * gg.w;
      xo[lane + i * 64] = y[i];
      ss2 += y[i].x * y[i].x + y[i].y * y[i].y + y[i].z * y[i].z + y[i].w * y[i].w;
    }
    if (gnext) {
      ss2 = wave_sum(ss2);
      const float r2 = rsqrtf(ss2 * (1.f / 1024.f) + 1e-6f);
#pragma unroll
      for (int i = 0; i < 4; i++) {
        const float4 gg = ((const float4*)gnext)[lane + i * 64];
        yr[lane + i * 64] = make_uint2(pack2(y[i].x * r2 * gg.x, y[i].y * r2 * gg.y), pack2(y[i].z * r2 * gg.z, y[i].w * r2 * gg.w));
      }
    }
  }
}

namespace pg8 {
#define PG8_LAS __attribute__((address_space(3)))
typedef unsigned short bf16_t;
typedef short bf16x8 __attribute__((ext_vector_type(8)));
typedef float f32x4 __attribute__((ext_vector_type(4)));
typedef unsigned u32x4 __attribute__((ext_vector_type(4)));
constexpr int BM = 256, BK = 64, HALF = 128, HTB = HALF * BK * 2  , STAGE_BYTES = 8 * HTB, NXCD = 8, WGM = 8;

__host__ __device__ __forceinline__ int lds_byte(int r, int c) { const int st = (r >> 4) * 2 + (c >> 5), rr = r & 15, cc = c & 31, ob = rr * 64 + cc * 2; return st * 1024 + (ob ^ (((ob >> 9) & 1) << 5)); }
__host__ __device__ __forceinline__ void stage_rc(int b, int& R, int& C) { const int st = b / 1024, sb = b % 1024, swz = sb ^ (((sb >> 9) & 1) << 5); R = (st >> 1) * 16 + swz / 64; C = (st & 1) * 32 + (swz % 64) / 2; }
__host__ __device__ __forceinline__ int perm32(int rho) { const int n = rho >> 4, i = rho & 15; return 8 * (i >> 2) + 4 * n + (i & 3); }

struct Unit { int pm, pn; };
struct Gemm { const bf16_t* A; const bf16_t* Bt; int M, N, K; };

struct StaticOrder {
    int nM, nN, nwg, G, c;
    __host__ __device__ void init(int M, int N, int G_, int c_) { nM = M / BM; nN = N / BM; nwg = nM * nN; G = G_; c = c_; }
    __host__ __device__ bool next(int i, Unit& u) const {
        const long L = (long)i * G + c; if (L >= nwg) return false;
        int wgid = (int)L; { const int q = nwg / NXCD, r = nwg % NXCD, xcd = wgid % NXCD, off = wgid / NXCD; wgid = (xcd < r ? xcd * (q + 1) : r * (q + 1) + (xcd - r) * q) + off; }
        const int nig = WGM * nN, gid = wgid / nig, fm = gid * WGM, gsz = (nM - fm) < WGM ? (nM - fm) : WGM;
        u.pm = fm + ((wgid % nig) % gsz); u.pn = (wgid % nig) / gsz; return true;
    }
    __device__ __forceinline__ void a_ready(const Unit&) const {}
    __device__ __forceinline__ void done(const Unit&) const {}
};
__device__ __forceinline__ unsigned cvt_pk_bf16(float lo, float hi) { unsigned r; asm volatile("v_cvt_pk_bf16_f32 %0, %1, %2" : "=v"(r) : "v"(lo), "v"(hi)); return r; }
typedef float f32x2 __attribute__((ext_vector_type(2)));

struct EpiStoreP {
    static constexpr bool PERM = true, AFTER_DRAIN = false;
    bf16_t* O; int ldc; int nvalid;
    __device__ __forceinline__ void operator()(const f32x4 (&acc)[2][2][4][2], const Unit& u, int wr, int wc, int fr, int fq) const {
        const int row0 = u.pm * BM + wr * 64 + fr, col0 = u.pn * BM + wc * 32 + 8 * fq;
#pragma unroll
        for (int ai = 0; ai < 2; ++ai)
#pragma unroll
            for (int m = 0; m < 4; ++m) { bf16_t* rowp = O + (size_t)(row0 + ai * HALF + m * 16) * ldc + col0;
#pragma unroll
                for (int bj = 0; bj < 2; ++bj) if (col0 + bj * HALF < nvalid) {
                    const f32x4 v0 = acc[ai][bj][m][0], v1 = acc[ai][bj][m][1];
                    u32x4 w; w.x = cvt_pk_bf16(v0[0], v0[1]); w.y = cvt_pk_bf16(v0[2], v0[3]); w.z = cvt_pk_bf16(v1[0], v1[1]); w.w = cvt_pk_bf16(v1[2], v1[3]);
                    *(u32x4*)(rowp + bj * HALF) = w; } }
    }
};
struct EpiSwigluP {
    static constexpr bool PERM = true, AFTER_DRAIN = false;
    bf16_t* O;
    static __device__ __forceinline__ float sg(float g, float uu) { return g * __builtin_amdgcn_rcpf(1.f + __expf(-g)) * uu; }
    __device__ __forceinline__ void operator()(const f32x4 (&acc)[2][2][4][2], const Unit& u, int wr, int wc, int fr, int fq) const {
        const int row0 = u.pm * BM + wr * 64 + fr, col0 = u.pn * HALF + wc * 32 + 8 * fq;
#pragma unroll
        for (int ai = 0; ai < 2; ++ai)
#pragma unroll
            for (int m = 0; m < 4; ++m) {
                const f32x4 g0 = acc[ai][0][m][0], g1 = acc[ai][0][m][1], u0 = acc[ai][1][m][0], u1 = acc[ai][1][m][1];
                u32x4 w; w.x = cvt_pk_bf16(sg(g0[0], u0[0]), sg(g0[1], u0[1])); w.y = cvt_pk_bf16(sg(g0[2], u0[2]), sg(g0[3], u0[3]));
                w.z = cvt_pk_bf16(sg(g1[0], u1[0]), sg(g1[1], u1[1])); w.w = cvt_pk_bf16(sg(g1[2], u1[2]), sg(g1[3], u1[3]));
                *(u32x4*)(O + (size_t)(row0 + ai * HALF + m * 16) * 2816 + col0) = w; }
    }
};
template <class Epi, class Sched, bool STAMP = false>
__device__ __forceinline__ void gemm_phase(PG8_LAS unsigned char* lds, const Gemm g, const Sched& S, const Epi& E, unsigned long long* stamps) {
    int tid = threadIdx.x; asm volatile("" : "+v"(tid));
    const int wid = __builtin_amdgcn_readfirstlane(tid >> 6), lane = tid & 63, wr = wid >> 2, wc = wid & 3, fr = lane & 15, fq = lane >> 4;
    const int K = g.K, nt = K / BK;
    int ts_lo = 0, ts_hi = 0, nts = 0; const unsigned long long rt_entry = STAMP ? (unsigned long long)wall_clock64() : 0ull;
#define PG8_STAMP() do { if (STAMP && wid == 0 && nts < 64) { const unsigned long long _c = (unsigned long long)clock64(); \
        ts_lo = (lane == nts) ? (int)(unsigned)_c : ts_lo; ts_hi = (lane == nts) ? (int)(unsigned)(_c >> 32) : ts_hi; ++nts; } } while (0)
    PG8_STAMP();
    unsigned voffA[2], voffB[2];
#pragma unroll
    for (int i = 0; i < 2; ++i) { int R, C; stage_rc(tid * 16 + i * 8192, R, C); const int Rb = Epi::PERM ? ((R & ~31) + perm32(R & 31)) : R;
        voffA[i] = (unsigned)(R * K + C) * 2u; voffB[i] = (unsigned)(Rb * K + C) * 2u; }
    const size_t kstep = (size_t)(BK * 2);
    const size_t hstep = (size_t)HALF * K * 2;
    const size_t tstep = 2 * hstep;
    const unsigned ldsw = (unsigned)wid * 1024u;
    const int aoff = lds_byte(wr * 64 + fr, fq * 8), boff = lds_byte(wc * 32 + fr, fq * 8);
#define PG8_SA(b, h) (((b) * 2 + (h)) * HTB)
#define PG8_SB(b, h) ((4 + (b) * 2 + (h)) * HTB)
#define PG8_STAGE(bufoff, gbase, voff) do { _Pragma("unroll") for (int _i = 0; _i < 2; ++_i) \
        __builtin_amdgcn_global_load_lds((const unsigned*)((const char*)(gbase) + (voff)[_i]), (PG8_LAS unsigned*)(lds + (bufoff) + ldsw + _i * 8192), 16, 0, 0); } while (0)
#define PG8_LDA(dst, b, h) do { _Pragma("unroll") for (int m = 0; m < 4; ++m) _Pragma("unroll") for (int k = 0; k < 2; ++k) dst[m][k] = *(const PG8_LAS bf16x8*)(lds + PG8_SA(b, h) + aoff + m * 2048 + k * 1024); } while (0)
#define PG8_LDB(dst, b, h) do { _Pragma("unroll") for (int n = 0; n < 2; ++n) _Pragma("unroll") for (int k = 0; k < 2; ++k) dst[n][k] = *(const PG8_LAS bf16x8*)(lds + PG8_SB(b, h) + boff + n * 2048 + k * 1024); } while (0)
#define PG8_MMA(ai, bj, At, Bt) do { __builtin_amdgcn_s_setprio(1); _Pragma("unroll") for (int m = 0; m < 4; ++m) _Pragma("unroll") for (int n = 0; n < 2; ++n) _Pragma("unroll") for (int k = 0; k < 2; ++k) \
        acc[ai][bj][m][n] = __builtin_amdgcn_mfma_f32_16x16x32_bf16(Bt[n][k], At[m][k], acc[ai][bj][m][n], 0, 0, 0); __builtin_amdgcn_s_setprio(0); } while (0)
#define PG8_WAIT_V(n) asm volatile("s_waitcnt vmcnt(" #n ")" ::: "memory")
#define PG8_WAIT_L(n) asm volatile("s_waitcnt lgkmcnt(" #n ")" ::: "memory")
#define PG8_BAR __builtin_amdgcn_s_barrier()
#define PG8_SCHED __builtin_amdgcn_sched_barrier(0)
    Unit cur, nxt; int ui = 0;
    if (!S.next(0, cur)) return;
    f32x4 acc[2][2][4][2];
#pragma unroll
    for (int a = 0; a < 2; ++a)
#pragma unroll
        for (int b = 0; b < 2; ++b)
#pragma unroll
            for (int m = 0; m < 4; ++m)
#pragma unroll
                for (int n = 0; n < 2; ++n) acc[a][b][m][n] = (f32x4){0.f, 0.f, 0.f, 0.f};
    bf16x8 At[4][2], B0[2][2], B1[2][2];
    const char* cA = (const char*)g.A + (size_t)cur.pm * tstep; const char* cB = (const char*)g.Bt + (size_t)cur.pn * tstep;
    S.a_ready(cur);
    PG8_STAGE(PG8_SB(0, 0), cB, voffB); PG8_STAGE(PG8_SA(0, 0), cA, voffA); PG8_STAGE(PG8_SB(0, 1), cB + hstep, voffB); PG8_STAGE(PG8_SA(0, 1), cA + hstep, voffA);
    if (wr == 1) PG8_BAR;
    PG8_WAIT_V(4); PG8_BAR;
    PG8_STAGE(PG8_SB(1, 0), cB + kstep, voffB); PG8_STAGE(PG8_SA(1, 0), cA + kstep, voffA); PG8_STAGE(PG8_SB(1, 1), cB + hstep + kstep, voffB);
    PG8_WAIT_V(6); PG8_BAR;
    PG8_STAMP();
    for (;;) {
        const bool has_next = S.next(ui + 1, nxt);
        const char* nA = has_next ? (const char*)g.A + (size_t)nxt.pm * tstep : cA; const char* nB = has_next ? (const char*)g.Bt + (size_t)nxt.pn * tstep : cB;
        for (int t = 0; t < nt; t += 2) {
            const bool last = (t == nt - 2);
            const char* a1 = cA + (size_t)(t + 1) * kstep;
            const char* a2 = last ? nA : cA + (size_t)(t + 2) * kstep; const char* b2 = last ? nB : cB + (size_t)(t + 2) * kstep;
            const char* a3 = a2 + kstep; const char* b3 = b2 + kstep;
            if (last && has_next) S.a_ready(nxt);
            PG8_LDB(B0, 0, 0); PG8_SCHED; PG8_LDA(At, 0, 0); PG8_STAGE(PG8_SA(1, 1), a1 + hstep, voffA);
            PG8_WAIT_L(8); PG8_BAR; PG8_WAIT_L(0); PG8_MMA(0, 0, At, B0); PG8_BAR; PG8_SCHED;
            PG8_LDB(B1, 0, 1); PG8_STAGE(PG8_SB(0, 0), b2, voffB);
            PG8_BAR; PG8_WAIT_L(0); PG8_MMA(0, 1, At, B1); PG8_BAR;
            PG8_LDA(At, 0, 1); PG8_STAGE(PG8_SA(0, 0), a2, voffA);
            PG8_BAR; PG8_WAIT_L(0); PG8_MMA(1, 0, At, B0); PG8_BAR; PG8_SCHED;
            PG8_STAGE(PG8_SB(0, 1), b2 + hstep, voffB);
            PG8_WAIT_V(6); PG8_BAR; PG8_MMA(1, 1, At, B1); PG8_BAR;
            PG8_LDB(B0, 1, 0); PG8_SCHED; PG8_LDA(At, 1, 0); PG8_STAGE(PG8_SA(0, 1), a2 + hstep, voffA);
            PG8_WAIT_L(8); PG8_BAR; PG8_WAIT_L(0); PG8_MMA(0, 0, At, B0); PG8_BAR; PG8_SCHED;
            PG8_LDB(B1, 1, 1); PG8_STAGE(PG8_SB(1, 0), b3, voffB);
            PG8_BAR; PG8_WAIT_L(0); PG8_MMA(0, 1, At, B1); PG8_BAR;
            PG8_LDA(At, 1, 1); PG8_STAGE(PG8_SA(1, 0), a3, voffA);
            PG8_BAR; PG8_WAIT_L(0); PG8_MMA(1, 0, At, B0); PG8_BAR; PG8_SCHED;
            PG8_STAGE(PG8_SB(1, 1), b3 + hstep, voffB);
            PG8_WAIT_V(6); PG8_BAR; PG8_MMA(1, 1, At, B1); PG8_BAR;
        }
        PG8_STAMP();
        if constexpr (!Epi::AFTER_DRAIN) { E(acc, cur, wr, wc, fr, fq); S.done(cur); }
        PG8_STAMP();
        if (!has_next) break;
#pragma unroll
        for (int a = 0; a < 2; ++a)
#pragma unroll
            for (int b = 0; b < 2; ++b)
#pragma unroll
                for (int m = 0; m < 4; ++m)
#pragma unroll
                    for (int n = 0; n < 2; ++n) acc[a][b][m][n] = (f32x4){0.f, 0.f, 0.f, 0.f};
        cur = nxt; cA = nA; cB = nB; ++ui;
    }
    PG8_WAIT_V(0);
    if (wr == 0) PG8_BAR;
    PG8_BAR;
    if constexpr (Epi::AFTER_DRAIN) { E.fused(acc, cur, wr, wc, fr, fq, lds, wid, lane); S.done(cur); }
    PG8_STAMP();
    if (STAMP && wid == 0) { stamps[lane] = lane < nts ? (((unsigned long long)(unsigned)ts_hi << 32) | (unsigned)ts_lo) : 0ull;
        if (lane == 62) stamps[62] = rt_entry; if (lane == 63) stamps[63] = (unsigned long long)wall_clock64(); }
#undef PG8_STAMP
#undef PG8_SA
#undef PG8_SB
#undef PG8_STAGE
#undef PG8_LDA
#undef PG8_LDB
#undef PG8_MMA
#undef PG8_WAIT_V
#undef PG8_WAIT_L
#undef PG8_BAR
#undef PG8_SCHED
}
}

#include <cstdio>
#include <ctime>
#include <cstdlib>
#include <cstring>
#include <cmath>
#include <vector>
#include <algorithm>

template <class Epi>
DI void phase_gemm(const bf16_t* A, const bf16_t* Bt, int N, int K, char* smem, const Epi& epi) {
  pg8::StaticOrder so;
  so.init(T_, N, (int)gridDim.x, (int)blockIdx.x);
  pg8::gemm_phase((PG8_LAS unsigned char*)smem, pg8::Gemm{A, Bt, T_, N, K}, so, epi, (unsigned long long*)nullptr);
}

template <int DQK>
DI void attn_tile(char* smem, const bf16_t* __restrict__ qp, int q_ld, const bf16_t* __restrict__ kp, int k_ld,
                  const bf16_t* __restrict__ k2p, int k2_ld, const bf16_t* __restrict__ vp, int v_ld,
                  long tok_base, int tok_stride, int q0, int kv_lo, int kv_hi, int win, float scale2, float slope2,
                  int mode, float sink2, float* st_o, float* st_ml, int st_h, bf16_t* outp, int out_ld, const float2* __restrict__ qrope) {
  constexpr int KS = DQK + 8, VS = 72, NKS = DQK / 16, CPR = DQK / 8;
  bf16_t* Ks = (bf16_t*)smem;
  bf16_t* Vs = Ks + 64 * KS;
  const int tid = tidx(), lane = tid & 63, w = tid >> 6, l31 = lane & 31, hh = lane >> 5;
  const int qi = q0 + w * 32 + l31;
  const long qtok = tok_base + (long)qi * tok_stride;
  bf16x8 qf[NKS];
#pragma unroll
  for (int ks = 0; ks < NKS; ks++) qf[ks] = *(const bf16x8*)(qp + qtok * q_ld + ks * 16 + hh * 8);
  if (DQK == 96) {
    const float2* tp = qrope + (qtok & (S_ - 1)) * 16 + hh * 8;
    float r1[8], r2[8];
#pragma unroll
    for (int i = 0; i < 8; i++) {
      const float2 cs = tp[i];
      const float t1 = bf2f((bf16_t)qf[NKS - 2][i]), t2 = bf2f((bf16_t)qf[NKS - 1][i]);
      r1[i] = t1 * cs.x - t2 * cs.y; r2[i] = t2 * cs.x + t1 * cs.y;
    }
    qf[NKS - 2] = pack8(r1[0], r1[1], r1[2], r1[3], r1[4], r1[5], r1[6], r1[7]);
    qf[NKS - 1] = pack8(r2[0], r2[1], r2[2], r2[3], r2[4], r2[5], r2[6], r2[7]);
  }
  f32x16 o[2];
  float m = -1e30f, l = 0.f;
  if (mode == 2 || mode == 3) {
#pragma unroll
    for (int mb = 0; mb < 2; mb++)
#pragma unroll
      for (int g = 0; g < 4; g++) {
        const float4 v = *(const float4*)(st_o + qtok * 512 + st_h * 64 + mb * 32 + 8 * g + 4 * hh);
        o[mb][4 * g + 0] = v.x; o[mb][4 * g + 1] = v.y; o[mb][4 * g + 2] = v.z; o[mb][4 * g + 3] = v.w;
      }
    m = st_ml[qtok * 8 + st_h];
    l = st_ml[(long)T_ * 8 + qtok * 8 + st_h];
  } else {
#pragma unroll
    for (int mb = 0; mb < 2; mb++)
#pragma unroll
      for (int r = 0; r < 16; r++) o[mb][r] = 0.f;
  }
  const int q_lo = q0 + w * 32, q_hi = q_lo + 31;
  const int q4 = (lane & 15) >> 2, p4 = lane & 3, blk = (lane >> 4) & 1;

  const int kr0 = tid / CPR, kc0 = tid % CPR;
  const int kr1 = (tid + 512) / CPR, kc1 = (tid + 512) % CPR;
  const int vr = tid >> 3, vc = tid & 7;
  uint4 rk0, rk1 = make_uint4(0, 0, 0, 0), rv;
#define ATT_LOAD(KV0)                                                                                          \
  {                                                                                                            \
    const long t0 = tok_base + (long)((KV0) + kr0) * tok_stride;                                               \
    rk0 = (DQK == 96 && kc0 >= 8) ? *(const uint4*)(k2p + t0 * k2_ld + (kc0 - 8) * 8) : *(const uint4*)(kp + t0 * k_ld + kc0 * 8); \
    if (DQK == 96 && tid < 256) {                                                                              \
      const long t1 = tok_base + (long)((KV0) + kr1) * tok_stride;                                             \
      rk1 = (kc1 >= 8) ? *(const uint4*)(k2p + t1 * k2_ld + (kc1 - 8) * 8) : *(const uint4*)(kp + t1 * k_ld + kc1 * 8); \
    }                                                                                                          \
    const long t2 = tok_base + (long)((KV0) + vr) * tok_stride;                                                \
    rv = *(const uint4*)(vp + t2 * v_ld + vc * 8);                                                             \
  }
  ATT_LOAD(kv_lo)
  for (int kv0 = kv_lo; kv0 < kv_hi; kv0 += 64) {
    __syncthreads();
    *(uint4*)(Ks + kr0 * KS + kc0 * 8) = rk0;
    if (DQK == 96 && tid < 256) *(uint4*)(Ks + kr1 * KS + kc1 * 8) = rk1;
    *(uint4*)(Vs + vr * VS + vc * 8) = rv;
    __syncthreads();
    if (kv0 + 64 < kv_hi) ATT_LOAD(kv0 + 64)
    __builtin_amdgcn_sched_barrier(0);
    if (kv0 > q_hi || kv0 + 63 < q_lo - win) continue;

    f32x16 s[2];
#pragma unroll
    for (int kb = 0; kb < 2; kb++) {
#pragma unroll
      for (int r = 0; r < 16; r++) s[kb][r] = 0.f;
#pragma unroll
      for (int ks = 0; ks < NKS; ks++) {
        const bf16x8 a = lds_frag(Ks, KS, kb * 32, ks * 16, l31, hh);
        s[kb] = MFMA32(a, qf[ks], s[kb]);
      }
    }
    const bool full = (kv0 + 63 <= q_lo) && (kv0 >= q_hi - win) && (slope2 == 0.f);
    float mx = -INFINITY;
    if (full) {
#pragma unroll
      for (int kb = 0; kb < 2; kb++)
#pragma unroll
        for (int r = 0; r < 16; r++) { s[kb][r] *= scale2; mx = fmaxf(mx, s[kb][r]); }
    } else {
#pragma unroll
      for (int kb = 0; kb < 2; kb++)
#pragma unroll
        for (int r = 0; r < 16; r++) {
          const int rel = qi - (kv0 + kb * 32 + crow(r, hh));
          float v = s[kb][r] * scale2 - slope2 * (float)rel;
          v = (rel >= 0 && rel <= win) ? v : -INFINITY;
          s[kb][r] = v; mx = fmaxf(mx, v);
        }
    }
    mx = fmaxf(mx, __shfl_xor(mx, 32));
    const float mn = fmaxf(m, mx);
    const float alpha = ex2(m - mn);
    m = mn;
    float rs = 0.f;
#pragma unroll
    for (int kb = 0; kb < 2; kb++)
#pragma unroll
      for (int r = 0; r < 16; r++) { const float pv = ex2(s[kb][r] - mn); s[kb][r] = pv; rs += pv; }
    rs += __shfl_xor(rs, 32);
    l = l * alpha + rs;
#pragma unroll
    for (int mb = 0; mb < 2; mb++)
#pragma unroll
      for (int r = 0; r < 16; r++) o[mb][r] *= alpha;
#pragma unroll
    for (int kb = 0; kb < 2; kb++)
#pragma unroll
      for (int st = 0; st < 2; st++) {
        const bf16x8 pb = pack8(s[kb][8 * st + 0], s[kb][8 * st + 1], s[kb][8 * st + 2], s[kb][8 * st + 3],
                                s[kb][8 * st + 4], s[kb][8 * st + 5], s[kb][8 * st + 6], s[kb][8 * st + 7]);
#pragma unroll
        for (int mb = 0; mb < 2; mb++) {
          const bf16_t* base = Vs + (kb * 32 + 16 * st + 4 * hh + q4) * VS + mb * 32 + 16 * blk + 4 * p4;
          const s16x4 lo = tr_read(base);
          const s16x4 hi = tr_read(base + 8 * VS);
          const bf16x8 a = __builtin_shufflevector(lo, hi, 0, 1, 2, 3, 4, 5, 6, 7);
          o[mb] = MFMA32(a, pb, o[mb]);
        }
      }
  }
#undef ATT_LOAD
  if (mode == 1 || mode == 2) {
#pragma unroll
    for (int mb = 0; mb < 2; mb++)
#pragma unroll
      for (int g = 0; g < 4; g++)
        *(float4*)(st_o + qtok * 512 + st_h * 64 + mb * 32 + 8 * g + 4 * hh) =
            make_float4(o[mb][4 * g + 0], o[mb][4 * g + 1], o[mb][4 * g + 2], o[mb][4 * g + 3]);
    if (hh == 0) { st_ml[qtok * 8 + st_h] = m; st_ml[(long)T_ * 8 + qtok * 8 + st_h] = l; }
  } else {
    float mult;
    if (mode == 4) {
      const float mf = fmaxf(m, sink2);
      const float a = ex2(m - mf);
      mult = a * rcpf(l * a + ex2(sink2 - mf));
    } else {
      mult = rcpf(l);
    }
#pragma unroll
    for (int mb = 0; mb < 2; mb++)
#pragma unroll
      for (int g = 0; g < 4; g++)
        *(uint2*)(outp + qtok * out_ld + mb * 32 + 8 * g + 4 * hh) =
            make_uint2(pack2(o[mb][4 * g + 0] * mult, o[mb][4 * g + 1] * mult), pack2(o[mb][4 * g + 2] * mult, o[mb][4 * g + 3] * mult));
  }
}

DI void attnA_task(const Params& p, char* smem, int tau, int pat) {
  const int dil = (pat == 0) ? 1 : (pat == 1 ? 4 : 16);
  const int ntile = (S_ / dil) >> 8;
  const int bh = tau >> 6, rem = tau & 63;
  const int r = rem / ntile, n = rem % ntile;
  const int b = bh >> 3, h = bh & 7;
  const bf16_t* pj = (const bf16_t*)(p.ws + OFF_BIG);
  const int q0 = n * 256;
  const int kv_lo = (q0 >= 128) ? q0 - 128 : 0;
  const float slope2 = exp2f(-(float)(h + 1)) * (float)dil * LOG2E;
  const int mode = (pat == 0) ? 1 : (pat == 1 ? 2 : 3);
  attn_tile<64>(smem, pj + h * 64, 3088, pj + 512 + h * 64, 3088, nullptr, 0, pj + 1024 + h * 64, 3088,
                (long)b * S_ + r, dil, q0, kv_lo, q0 + 256, 128, 0.125f * LOG2E, slope2, mode, 0.f,
                (float*)(p.ws + OFF_HBUF), (float*)(p.ws + OFF_ML), h,
                (bf16_t*)(p.ws + OFF_MIX) + h * 64, 1024, nullptr);
}

DI void attnC_task(const Params& p, char* smem, int tau) {
  const int b = tau >> 9, hq = (tau >> 6) & 7, tile = tau & 63;
  const int kvh = hq >> 2;
  const bf16_t* pj = (const bf16_t*)(p.ws + OFF_P1);
  const int q0 = tile * 256;
  const int kv_lo = (q0 >= 128) ? q0 - 128 : 0;
  attn_tile<64>(smem, pj + hq * 64, 1440, pj + 512 + kvh * 64, 1440, nullptr, 0, pj + 640 + kvh * 64, 1440,
                (long)b * S_, 1, q0, kv_lo, q0 + 256, 127, 0.125f * LOG2E, exp2f(-(float)(hq + 1)) * LOG2E, 4,
                p.sinks[hq] * LOG2E, nullptr, nullptr, 0, (bf16_t*)(p.ws + OFF_MIX) + hq * 64, 1024, nullptr);
}

DI void attnD_task(const Params& p, char* smem, int tau) {
  const int bh = tau >> 5, i = tau & 31;
  const int b = bh >> 3, h = bh & 7;
  const bf16_t* qb = (const bf16_t*)(p.ws + OFF_Q);
  const bf16_t* kv = (const bf16_t*)(p.ws + OFF_KV);
  const bf16_t* kpe = (const bf16_t*)(p.ws + OFF_KPE);
  const float scale2 = 0.10206207261596575f * LOG2E;
#pragma unroll 1
  for (int u = 0; u < 2; u++) {
    const int tile = u ? i : (63 - i);
    const int q0 = tile * 256;
    attn_tile<96>(smem, qb + h * 96, 768, kv + h * 128, 1024, kpe, 32, kv + h * 128 + 64, 1024,
                  (long)b * S_, 1, q0, 0, q0 + 256, 1 << 30, scale2, 0.f, 0, 0.f, nullptr, nullptr, 0,
                  (bf16_t*)(p.ws + OFF_MIX) + 512 + h * 64, 1024, (const float2*)(p.ws + OFF_ROPE));
  }
}

DI void gla_gate(const Params& p, float* bc, long tok0, int h, int tid) {
  const bf16_t* pj = (const bf16_t*)(p.ws + OFF_BIG);
  const int d = tid & 63, sg = tid >> 6;
  float wc[16];
#pragma unroll
  for (int r = 0; r < 16; r++) wc[r] = p.gla_wg[r * 256 + h * 64 + d];
  const float bias = p.gla_bg[h * 64 + d];
#pragma unroll 1
  for (int i = 0; i < 16; i++) {
    const int s = sg * 16 + i;
    const uint4* gp = (const uint4*)(pj + (tok0 + s) * 3088 + 3072);
    const uint4 g0 = gp[0], g1 = gp[1];
    float x = bias;
    x += bflo(g0.x) * wc[0] + bfhi(g0.x) * wc[1] + bflo(g0.y) * wc[2] + bfhi(g0.y) * wc[3];
    x += bflo(g0.z) * wc[4] + bfhi(g0.z) * wc[5] + bflo(g0.w) * wc[6] + bfhi(g0.w) * wc[7];
    x += bflo(g1.x) * wc[8] + bfhi(g1.x) * wc[9] + bflo(g1.y) * wc[10] + bfhi(g1.y) * wc[11];
    x += bflo(g1.z) * wc[12] + bfhi(g1.z) * wc[13] + bflo(g1.w) * wc[14] + bfhi(g1.w) * wc[15];
    const float ls = fminf(x, 0.f) - __logf(1.f + __expf(-fabsf(x)));
    bc[s * 64 + d] = ls * (1.f / 16.f);
  }
  __syncthreads();
  if (tid < 64) {
    float c = 0.f;
#pragma unroll 8
    for (int s = 0; s < 64; s++) { c += bc[s * 64 + tid]; bc[s * 64 + tid] = c; }
  }
  __syncthreads();
}

DI void gla_stage_vt(const Params& p, bf16_t* Vt, long tok0, int h, int tid) {
  const bf16_t* pj = (const bf16_t*)(p.ws + OFF_BIG);
  const int e = tid & 127, sg2 = tid >> 7;
  unsigned wv[16];
#pragma unroll
  for (int j = 0; j < 16; j++) {
    const unsigned lo = pj[(tok0 + sg2 * 32 + 2 * j) * 3088 + 2048 + h * 128 + e];
    const unsigned hi = pj[(tok0 + sg2 * 32 + 2 * j + 1) * 3088 + 2048 + h * 128 + e];
    wv[j] = lo | (hi << 16);
  }
  uint4* dp = (uint4*)(Vt + e * 72 + sg2 * 32);
  dp[0] = make_uint4(wv[0], wv[1], wv[2], wv[3]);
  dp[1] = make_uint4(wv[4], wv[5], wv[6], wv[7]);
  dp[2] = make_uint4(wv[8], wv[9], wv[10], wv[11]);
  dp[3] = make_uint4(wv[12], wv[13], wv[14], wv[15]);
}

DI void gla_a_task(const Params& p, char* smem, int task) {
  const int tid = tidx() & 255, lane = tid & 63, w = tid >> 6, l31 = lane & 31, hh = lane >> 5;
  smem += (tidx() >> 8) * 73728;
  const int bh = task >> 8, n = task & 255, b = bh >> 2, h = bh & 3;
  const long tok0 = (long)b * S_ + n * 64;
  float* bc = (float*)smem;
  bf16_t* Vt = (bf16_t*)(smem + 34816);
  bf16_t* KdT = (bf16_t*)(smem + 53248);
  const bf16_t* pj = (const bf16_t*)(p.ws + OFF_BIG);
  gla_gate(p, bc, tok0, h, tid);
  {
    const int d = tid & 63, sg = tid >> 6;
    const float bl = bc[63 * 64 + d];
    unsigned wv[8];
#pragma unroll
    for (int j = 0; j < 8; j++) {
      const int s0 = sg * 16 + 2 * j;
      const float k0 = bf2f(pj[(tok0 + s0) * 3088 + 1792 + h * 64 + d]) * __expf(bl - bc[s0 * 64 + d]);
      const float k1 = bf2f(pj[(tok0 + s0 + 1) * 3088 + 1792 + h * 64 + d]) * __expf(bl - bc[(s0 + 1) * 64 + d]);
      wv[j] = pack2(k0, k1);
    }
    uint4* dp = (uint4*)(KdT + d * 72 + sg * 16);
    dp[0] = make_uint4(wv[0], wv[1], wv[2], wv[3]);
    dp[1] = make_uint4(wv[4], wv[5], wv[6], wv[7]);
  }
  gla_stage_vt(p, Vt, tok0, h, tid);
  __syncthreads();
  f32x16 acc[2];
#pragma unroll
  for (int nb = 0; nb < 2; nb++)
#pragma unroll
    for (int r = 0; r < 16; r++) acc[nb][r] = 0.f;
#pragma unroll
  for (int ks = 0; ks < 4; ks++) {
    const bf16x8 a = lds_frag(Vt, 72, w * 32, ks * 16, l31, hh);
#pragma unroll
    for (int nb = 0; nb < 2; nb++) {
      const bf16x8 bb = lds_frag(KdT, 72, nb * 32, ks * 16, l31, hh);
      acc[nb] = MFMA32(a, bb, acc[nb]);
    }
  }
  float* dst = (float*)((char*)p.out + OUT_DST) + (long)task * 8192;
#pragma unroll
  for (int nb = 0; nb < 2; nb++)
#pragma unroll
    for (int r = 0; r < 16; r++) dst[(w * 32 + crow(r, hh)) * 64 + nb * 32 + l31] = acc[nb][r];
  if (tid < 64) ((float*)((char*)p.out + OUT_DEC))[task * 64 + tid] = __expf(bc[63 * 64 + tid]);
  __syncthreads();
}

DI void gla_scan_item(const Params& p, int item) {
  const int idx = item * NTHR + tidx();
  const int bh = idx >> 13, ed = idx & 8191, d = ed & 63;
  const float* dS = (const float*)((char*)p.out + OUT_DST);
  const float* dec = (const float*)((char*)p.out + OUT_DEC);
  bf16_t* sp = (bf16_t*)((char*)p.out + OUT_SPT);
  float st = 0.f;
#pragma unroll 1
  for (int n = 0; n < 256; n += 8) {
    float ds[8], dc[8];
#pragma unroll
    for (int u = 0; u < 8; u++) {
      const long task = bh * 256 + n + u;
      ds[u] = dS[task * 8192 + ed];
      dc[u] = dec[task * 64 + d];
    }
#pragma unroll
    for (int u = 0; u < 8; u++) {
      const long task = bh * 256 + n + u;
      sp[task * 8192 + ed] = f2bf(st);
      st = dc[u] * st + ds[u];
    }
  }
}

DI void gla_c_task(const Params& p, char* smem, int task) {
  const int tid = tidx() & 255, lane = tid & 63, w = tid >> 6, l31 = lane & 31, hh = lane >> 5;
  smem += (tidx() >> 8) * 73728;
  const int bh = task >> 8, n = task & 255, b = bh >> 2, h = bh & 3;
  const long tok0 = (long)b * S_ + n * 64;
  float* bc = (float*)smem;
  bf16_t* att = (bf16_t*)smem;
  bf16_t* Qg = (bf16_t*)(smem + 16384);
  bf16_t* Kg = (bf16_t*)(smem + 25600);
  bf16_t* Vt = (bf16_t*)(smem + 34816);
  bf16_t* SpT = (bf16_t*)(smem + 53248);
  float* red = (float*)(smem + 71680);
  const bf16_t* pj = (const bf16_t*)(p.ws + OFF_BIG);
  gla_gate(p, bc, tok0, h, tid);
  {
    const int d = tid & 63, sg = tid >> 6;
    const float bm = bc[31 * 64 + d];
#pragma unroll 4
    for (int i = 0; i < 16; i++) {
      const int s = sg * 16 + i;
      const float bb = bc[s * 64 + d];
      const float qv = bf2f(pj[(tok0 + s) * 3088 + 1536 + h * 64 + d]);
      const float kv = bf2f(pj[(tok0 + s) * 3088 + 1792 + h * 64 + d]);
      Qg[s * 72 + d] = f2bf(qv * 0.125f * __expf(bb - bm));
      Kg[s * 72 + d] = f2bf(kv * __expf(bm - bb));
    }
  }
  gla_stage_vt(p, Vt, tok0, h, tid);
  {
    const int e = tid >> 1, hf = tid & 1;
    const uint4* sp = (const uint4*)((const bf16_t*)((char*)p.out + OUT_SPT) + (long)task * 8192 + e * 64 + hf * 32);
    uint4* dp = (uint4*)(SpT + e * 72 + hf * 32);
#pragma unroll
    for (int c = 0; c < 4; c++) {
      const uint4 v = sp[c];
      const int d0 = hf * 32 + c * 8;
      uint4 o;
      o.x = pack2(bflo(v.x) * __expf(bc[31 * 64 + d0 + 0]), bfhi(v.x) * __expf(bc[31 * 64 + d0 + 1]));
      o.y = pack2(bflo(v.y) * __expf(bc[31 * 64 + d0 + 2]), bfhi(v.y) * __expf(bc[31 * 64 + d0 + 3]));
      o.z = pack2(bflo(v.z) * __expf(bc[31 * 64 + d0 + 4]), bfhi(v.z) * __expf(bc[31 * 64 + d0 + 5]));
      o.w = pack2(bflo(v.w) * __expf(bc[31 * 64 + d0 + 6]), bfhi(v.w) * __expf(bc[31 * 64 + d0 + 7]));
      dp[c] = o;
    }
  }
  __syncthreads();
  {
    const int mb = w & 1, nb = w >> 1;
    f32x16 a2;
#pragma unroll
    for (int r = 0; r < 16; r++) a2[r] = 0.f;
#pragma unroll
    for (int ks = 0; ks < 4; ks++) {
      const bf16x8 a = lds_frag(Qg, 72, mb * 32, ks * 16, l31, hh);
      const bf16x8 bb = lds_frag(Kg, 72, nb * 32, ks * 16, l31, hh);
      a2 = MFMA32(a, bb, a2);
    }
#pragma unroll
    for (int r = 0; r < 16; r++) {
      const int c = mb * 32 + crow(r, hh), s = nb * 32 + l31;
      att[c * 72 + s] = f2bf((s <= c) ? a2[r] : 0.f);
    }
  }
  __syncthreads();
  f32x16 acc[2];
#pragma unroll
  for (int nb = 0; nb < 2; nb++)
#pragma unroll
    for (int r = 0; r < 16; r++) acc[nb][r] = 0.f;
#pragma unroll
  for (int ks = 0; ks < 4; ks++) {
    const bf16x8 a = lds_frag(Vt, 72, w * 32, ks * 16, l31, hh);
#pragma unroll
    for (int nb = 0; nb < 2; nb++) acc[nb] = MFMA32(a, lds_frag(att, 72, nb * 32, ks * 16, l31, hh), acc[nb]);
  }
#pragma unroll
  for (int ks = 0; ks < 4; ks++) {
    const bf16x8 a = lds_frag(SpT, 72, w * 32, ks * 16, l31, hh);
#pragma unroll
    for (int nb = 0; nb < 2; nb++) acc[nb] = MFMA32(a, lds_frag(Qg, 72, nb * 32, ks * 16, l31, hh), acc[nb]);
  }
#pragma unroll
  for (int nb = 0; nb < 2; nb++) {
    float ss = 0.f;
#pragma unroll
    for (int r = 0; r < 16; r++) ss += acc[nb][r] * acc[nb][r];
    ss += __shfl_xor(ss, 32);
    if (hh == 0) red[w * 64 + nb * 32 + l31] = ss;
  }
  __syncthreads();
  bf16_t* mix = (bf16_t*)(p.ws + OFF_MIX);
#pragma unroll
  for (int nb = 0; nb < 2; nb++) {
    const int c = nb * 32 + l31;
    const float tot = red[c] + red[64 + c] + red[128 + c] + red[192 + c];
    const float rn = rsqrtf(tot * (1.f / 128.f) + 1e-6f);
    const long tok = tok0 + c;
#pragma unroll
    for (int g = 0; g < 4; g++) {
      const int e0 = w * 32 + 8 * g + 4 * hh;
      const float4 gn = *(const float4*)(p.gla_norm + e0);
      const uint2 rr = *(const uint2*)(pj + tok * 3088 + 2560 + h * 128 + e0);
      const float o0 = acc[nb][4 * g + 0] * rn * gn.x * siluf(bflo(rr.x));
      const float o1 = acc[nb][4 * g + 1] * rn * gn.y * siluf(bfhi(rr.x));
      const float o2 = acc[nb][4 * g + 2] * rn * gn.z * siluf(bflo(rr.y));
      const float o3 = acc[nb][4 * g + 3] * rn * gn.w * siluf(bfhi(rr.y));
      *(uint2*)(mix + tok * 1024 + 512 + h * 128 + e0) = make_uint2(pack2(o0, o1), pack2(o2, o3));
    }
  }
  __syncthreads();
}

DI void phase_latent(const Params& p) {
  const int lane = tidx() & 63, w = tidx() >> 6;
  const bf16_t* pj = (const bf16_t*)(p.ws + OFF_P1);
  bf16_t* cqn = (bf16_t*)(p.ws + OFF_CQN);
  bf16_t* ckvn = (bf16_t*)(p.ws + OFF_CKVN);
  bf16_t* kpe = (bf16_t*)(p.ws + OFF_KPE);
  const float2* tab = (const float2*)(p.ws + OFF_ROPE);
  for (int row = blockIdx.x * 8 + w; row < T_; row += gridDim.x * 8) {
    const bf16_t* pr = pj + (long)row * 1440;
    uint4 a = make_uint4(0, 0, 0, 0), c = make_uint4(0, 0, 0, 0);
    if (lane < 48) a = *(const uint4*)(pr + 768 + lane * 8);
    if (lane < 32) c = *(const uint4*)(pr + 1152 + lane * 8);
    float av[8] = {bflo(a.x), bfhi(a.x), bflo(a.y), bfhi(a.y), bflo(a.z), bfhi(a.z), bflo(a.w), bfhi(a.w)};
    float cv[8] = {bflo(c.x), bfhi(c.x), bflo(c.y), bfhi(c.y), bflo(c.z), bfhi(c.z), bflo(c.w), bfhi(c.w)};
    float sa = 0.f, sc = 0.f;
#pragma unroll
    for (int j = 0; j < 8; j++) { sa += av[j] * av[j]; sc += cv[j] * cv[j]; }
    sa = wave_sum(sa); sc = wave_sum(sc);
    const float ra = rsqrtf(sa * (1.f / 384.f) + 1e-6f), rc = rsqrtf(sc * (1.f / 256.f) + 1e-6f);
    if (lane < 48) {
      const float4 g0 = *(const float4*)(p.q_norm + lane * 8), g1 = *(const float4*)(p.q_norm + lane * 8 + 4);
      *(uint4*)(cqn + (long)row * 384 + lane * 8) =
          make_uint4(pack2(av[0] * ra * g0.x, av[1] * ra * g0.y), pack2(av[2] * ra * g0.z, av[3] * ra * g0.w),
                     pack2(av[4] * ra * g1.x, av[5] * ra * g1.y), pack2(av[6] * ra * g1.z, av[7] * ra * g1.w));
    }
    if (lane < 32) {
      const float4 g0 = *(const float4*)(p.kv_norm + lane * 8), g1 = *(const float4*)(p.kv_norm + lane * 8 + 4);
      *(uint4*)(ckvn + (long)row * 256 + lane * 8) =
          make_uint4(pack2(cv[0] * rc * g0.x, cv[1] * rc * g0.y), pack2(cv[2] * rc * g0.z, cv[3] * rc * g0.w),
                     pack2(cv[4] * rc * g1.x, cv[5] * rc * g1.y), pack2(cv[6] * rc * g1.z, cv[7] * rc * g1.w));
    }
    if (lane < 16) {
      const float t1 = bf2f(pr[1408 + lane]), t2 = bf2f(pr[1408 + 16 + lane]);
      const float2 cs = tab[(row & (S_ - 1)) * 16 + lane];
      kpe[(long)row * 32 + lane] = f2bf(t1 * cs.x - t2 * cs.y);
      kpe[(long)row * 32 + 16 + lane] = f2bf(t2 * cs.x + t1 * cs.y);
    }
  }
}

DI void grid_bar(unsigned* ctr, unsigned target) {
  asm volatile("s_waitcnt vmcnt(0)" ::: "memory");
  __syncthreads();
  if (threadIdx.x == 0) {
    __builtin_amdgcn_fence(__ATOMIC_RELEASE, "agent");
    asm volatile("s_waitcnt vmcnt(0)" ::: "memory");
    __hip_atomic_fetch_add(ctr, 1u, __ATOMIC_RELAXED, __HIP_MEMORY_SCOPE_AGENT);
    unsigned spins = 0;
    while (__hip_atomic_load(ctr, __ATOMIC_RELAXED, __HIP_MEMORY_SCOPE_AGENT) < target && ++spins < (1u << 22)) __builtin_amdgcn_s_sleep(1);
    __builtin_amdgcn_fence(__ATOMIC_ACQUIRE, "agent");
    asm volatile("s_waitcnt vmcnt(0)" ::: "memory");
  }
  __syncthreads();
}

__global__ void __launch_bounds__(NTHR, 2) mega_kernel(Params p) {
  __shared__ __attribute__((aligned(16))) char smem[LDS_BYTES];
  cg::grid_group grid = cg::this_grid();
  char* ws = p.ws;
  bf16_t* hbuf = (bf16_t*)(ws + OFF_HBUF);
  bf16_t* mix = (bf16_t*)(ws + OFF_MIX);
  bf16_t* big = (bf16_t*)(ws + OFF_BIG);
  const int G = gridDim.x, bid = blockIdx.x, grp = tidx() >> 8;
  unsigned* bar = (unsigned*)(ws + OFF_BAR);

  phase_convert(p, smem);
  phase_rope_table(p);
  phase_rms_first(p.x, p.n_mix_pre, hbuf);
  grid.sync();
  phase_gemm(hbuf, (const bf16_t*)(ws + OFF_W0IN), 3328, 1024, smem, pg8::EpiStoreP{big, 3088, 3088});
  grid_bar(bar, (unsigned)(1 * G));
  for (int t = bid; t < 2048; t += G) { if (t < 1024) gla_a_task(p, smem, 2 * t + grp); else attnA_task(p, smem, t - 1024, 0); }
  grid_bar(bar, (unsigned)(2 * G));
  for (int t = bid; t < 128 + 1024; t += G) { if (t < 128) gla_scan_item(p, t); else attnA_task(p, smem, t - 128, 1); }
  grid_bar(bar, (unsigned)(3 * G));
  for (int t = bid; t < 2048; t += G) { if (t < 1024) gla_c_task(p, smem, 2 * t + grp); else attnA_task(p, smem, t - 1024, 2); }
  grid_bar(bar, (unsigned)(4 * G));
  phase_gemm(mix, (const bf16_t*)(ws + OFF_W0OUT), 1024, 1024, smem, pg8::EpiStoreP{hbuf, 1024, 1024});
  grid_bar(bar, (unsigned)(5 * G));
  phase_resid(p.x, p.out, hbuf, p.n_mix_post, p.n_ffn_pre);
  grid_bar(bar, (unsigned)(6 * G));
  phase_gemm(hbuf, (const bf16_t*)(ws + OFF_WGU0), 5632, 1024, smem, pg8::EpiSwigluP{big});
  grid_bar(bar, (unsigned)(7 * G));
  phase_gemm(big, (const bf16_t*)(ws + OFF_WDN0), 1024, 2816, smem, pg8::EpiStoreP{hbuf, 1024, 1024});
  grid_bar(bar, (unsigned)(8 * G));
  phase_resid(p.out, p.out, hbuf, p.n_ffn_post, p.n_mix_pre + 1024);
  grid_bar(bar, (unsigned)(9 * G));
  phase_gemm(hbuf, (const bf16_t*)(ws + OFF_W1IN), 1536, 1024, smem, pg8::EpiStoreP{(bf16_t*)(ws + OFF_P1), 1440, 1440});
  grid_bar(bar, (unsigned)(10 * G));
  phase_latent(p);
  grid_bar(bar, (unsigned)(11 * G));
  {
    phase_gemm((const bf16_t*)(ws + OFF_CQN), (const bf16_t*)(ws + OFF_WUQ), 768, 384, smem, pg8::EpiStoreP{(bf16_t*)(ws + OFF_Q), 768, 768});
    phase_gemm((const bf16_t*)(ws + OFF_CKVN), (const bf16_t*)(ws + OFF_WUKV), 1024, 256, smem, pg8::EpiStoreP{(bf16_t*)(ws + OFF_KV), 1024, 1024});
  }
  grid_bar(bar, (unsigned)(12 * G));
  for (int t = bid; t < 512 + 1024; t += G) { if (t < 512) attnD_task(p, smem, t); else attnC_task(p, smem, t - 512); }
  grid_bar(bar, (unsigned)(13 * G));
  phase_gemm(mix, (const bf16_t*)(ws + OFF_W1OUT), 1024, 1024, smem, pg8::EpiStoreP{hbuf, 1024, 1024});
  grid_bar(bar, (unsigned)(14 * G));
  phase_resid(p.out, p.out, hbuf, p.n_mix_post + 1024, p.n_ffn_pre + 1024);
  grid_bar(bar, (unsigned)(15 * G));
  phase_gemm(hbuf, (const bf16_t*)(ws + OFF_WGU1), 5632, 1024, smem, pg8::EpiSwigluP{big});
  grid_bar(bar, (unsigned)(16 * G));
  phase_gemm(big, (const bf16_t*)(ws + OFF_WDN1), 1024, 2816, smem, pg8::EpiStoreP{hbuf, 1024, 1024});
  grid_bar(bar, (unsigned)(17 * G));
  phase_resid(p.out, p.out, hbuf, p.n_ffn_post + 1024, nullptr);
}

extern "C" void kernel_launch(void* const* d_in, const int* in_sizes, int n_in, void* d_out, int out_size, void* d_ws,
                              size_t ws_size, hipStream_t stream) {
  static int grid_blocks = 0;
  if (!grid_blocks) {
    int dev = 0, cus = 0, per_cu = 0;
    hipGetDevice(&dev);
    hipDeviceGetAttribute(&cus, hipDeviceAttributeMultiprocessorCount, dev);
    hipOccupancyMaxActiveBlocksPerMultiprocessor(&per_cu, mega_kernel, NTHR, 0);
    if (per_cu < 1) per_cu = 1;
    grid_blocks = cus * per_cu;
  }
  if (ws_size < (size_t)WS_NEED) { fprintf(stderr, "workspace too small: %zu < %ld\n", ws_size, (long)WS_NEED); return; }
  Params p{};
  const float** f = (const float**)&p;
  for (int i = 0; i < 20; i++) f[i] = (const float*)d_in[i];
  p.out = (float*)d_out;
  p.ws = (char*)d_ws;
  hipMemsetAsync((char*)d_ws + OFF_BAR, 0, 256, stream);
  void* args[] = {&p};
  hipError_t e = hipLaunchCooperativeKernel((void*)mega_kernel, dim3(grid_blocks), dim3(NTHR), args, 0, stream);
  if (e != hipSuccess) fprintf(stderr, "cooperative launch failed: %s (grid %d)\n", hipGetErrorString(e), grid_blocks);
}
```

```cpp
#include <hip/hip_runtime.h>
#include <hip/hip_cooperative_groups.h>
#include <cstdio>
namespace cg = cooperative_groups;

typedef unsigned short bf16_t;
using bf16x8 = __attribute__((ext_vector_type(8))) short;
using s16x4  = __attribute__((ext_vector_type(4))) short;
using f32x16 = __attribute__((ext_vector_type(16))) float;
typedef __attribute__((ext_vector_type(2))) __bf16 bf2_t;
#define DI __device__ __forceinline__
#define MFMA32(a, b, c) __builtin_amdgcn_mfma_f32_32x32x16_bf16((a), (b), (c), 0, 0, 0)

constexpr int T_ = 32768, S_ = 16384;
constexpr float LOG2E = 1.4426950408889634f;
constexpr int LDS_BYTES = 147456;
constexpr int NTHR = 512;

constexpr long OFF_W0IN  = 0;
constexpr long OFF_W0OUT = OFF_W0IN  + 3328L * 1024 * 2;
constexpr long OFF_WGU0  = OFF_W0OUT + 1024L * 1024 * 2;
constexpr long OFF_WGU1  = OFF_WGU0  + 5632L * 1024 * 2;
constexpr long OFF_WDN0  = OFF_WGU1  + 5632L * 1024 * 2;
constexpr long OFF_WDN1  = OFF_WDN0  + 1024L * 2816 * 2;
constexpr long OFF_W1IN  = OFF_WDN1  + 1024L * 2816 * 2;
constexpr long OFF_W1OUT = OFF_W1IN  + 1536L * 1024 * 2;
constexpr long OFF_WUQ   = OFF_W1OUT + 1024L * 1024 * 2;
constexpr long OFF_WUKV  = OFF_WUQ   + 768L * 384 * 2;
constexpr long OFF_ROPE  = OFF_WUKV  + 1024L * 256 * 2;
constexpr long OFF_ML    = OFF_ROPE  + 16384L * 16 * 8;
constexpr long OFF_HBUF  = OFF_ML    + (long)T_ * 8 * 4 * 2;
constexpr long OFF_MIX   = OFF_HBUF  + (long)T_ * 1024 * 2;
constexpr long OFF_KV    = OFF_MIX   + (long)T_ * 1024 * 2;
constexpr long OFF_BIG   = OFF_KV    + (long)T_ * 1024 * 2;
constexpr long OFF_BAR   = OFF_BIG   + (long)T_ * 3088 * 2;
constexpr long WS_NEED   = OFF_BAR + 256;
constexpr long OFF_P1    = OFF_BIG;
constexpr long OFF_CQN   = OFF_P1   + (long)T_ * 1440 * 2;
constexpr long OFF_CKVN  = OFF_CQN  + (long)T_ * 384 * 2;
constexpr long OFF_KPE   = OFF_CKVN + (long)T_ * 256 * 2;
constexpr long OFF_Q     = OFF_KPE  + (long)T_ * 32 * 2;
constexpr long OUT_DST   = 0;
constexpr long OUT_SPT   = 2048L * 8192 * 4;
constexpr long OUT_DEC   = OUT_SPT + 2048L * 8192 * 2;

struct Params {
  const float *x, *n_mix_pre, *n_mix_post, *n_ffn_pre, *n_ffn_post, *ffn_g, *ffn_u, *ffn_d;
  const float *ab_in, *ab_out, *gla_wg, *gla_bg, *gla_norm, *cd_in, *cd_out, *sinks, *q_norm, *w_uq, *kv_norm, *w_ukv;
  float* out;
  char* ws;
};

DI int tidx() { int t = threadIdx.x; asm volatile("" : "+v"(t)); return t; }
DI unsigned pack2(float a, float b) { bf2_t v; v[0] = (__bf16)a; v[1] = (__bf16)b; return __builtin_bit_cast(unsigned, v); }
DI bf16_t f2bf(float a) { return __builtin_bit_cast(unsigned short, (__bf16)a); }
DI float bf2f(bf16_t v) { return __uint_as_float(((unsigned)v) << 16); }
DI float bflo(unsigned u) { return __uint_as_float(u << 16); }
DI float bfhi(unsigned u) { return __uint_as_float(u & 0xffff0000u); }
DI float ex2(float x) { return __builtin_amdgcn_exp2f(x); }
DI float rcpf(float x) { return __builtin_amdgcn_rcpf(x); }
DI float siluf(float x) { return x * rcpf(1.f + __expf(-x)); }
DI int crow(int reg, int hh) { return (reg & 3) + 8 * (reg >> 2) + 4 * hh; }
DI float wave_sum(float v) {
#pragma unroll
  for (int o = 32; o; o >>= 1) v += __shfl_xor(v, o);
  return v;
}
DI bf16x8 pack8(float a0, float a1, float a2, float a3, float a4, float a5, float a6, float a7) {
  uint4 u = make_uint4(pack2(a0, a1), pack2(a2, a3), pack2(a4, a5), pack2(a6, a7));
  return __builtin_bit_cast(bf16x8, u);
}
DI bf16x8 lds_frag(const bf16_t* base, int stride, int row0, int kofs, int l31, int hh) {
  return *(const bf16x8*)(base + (row0 + l31) * stride + kofs + hh * 8);
}
DI s16x4 tr_read(const bf16_t* p) {
  return __builtin_amdgcn_ds_read_tr16_b64_v4i16((__attribute__((address_space(3))) s16x4*)(p));
}

DI void phase_convert(const Params& p, char* smem) {
  const int tid = tidx() & 255, grp = tidx() >> 8;
  float* tl = (float*)(smem + grp * 16640);
  for (int it0 = blockIdx.x * 2; it0 < 6088; it0 += gridDim.x * 2) {
    const int it = it0 + grp;
    const float *sa, *sb; int K, N, mode = 0, t; long doff;
    if (it < 832)       { t = it;        sa = p.ab_in;  sb = sa; K = 1024; N = 3088; doff = OFF_W0IN; }
    else if (it < 1088) { t = it - 832;  sa = p.ab_out; sb = sa; K = 1024; N = 1024; doff = OFF_W0OUT; }
    else if (it < 2496) { t = it - 1088; sa = p.ffn_g;  sb = p.ffn_u; K = 1024; N = 2816; mode = 1; doff = OFF_WGU0; }
    else if (it < 3904) { t = it - 2496; sa = p.ffn_g + 1024L * 2816; sb = p.ffn_u + 1024L * 2816; K = 1024; N = 2816; mode = 1; doff = OFF_WGU1; }
    else if (it < 4608) { t = it - 3904; sa = p.ffn_d;  sb = sa; K = 2816; N = 1024; doff = OFF_WDN0; }
    else if (it < 5312) { t = it - 4608; sa = p.ffn_d + 2816L * 1024; sb = sa; K = 2816; N = 1024; doff = OFF_WDN1; }
    else if (it < 5696) { t = it - 5312; sa = p.cd_in;  sb = sa; K = 1024; N = 1440; doff = OFF_W1IN; }
    else if (it < 5952) { t = it - 5696; sa = p.cd_out; sb = sa; K = 1024; N = 1024; doff = OFF_W1OUT; }
    else if (it < 6024) { t = it - 5952; sa = p.w_uq;   sb = sa; K = 384;  N = 768;  doff = OFF_WUQ; }
    else                { t = it - 6024; sa = p.w_ukv;  sb = sa; K = 256;  N = 1024; doff = OFF_WUKV; }
    bf16_t* dst = (bf16_t*)(p.ws + doff);
    const int nkt = K >> 6;
    const int kt = t % nkt, nt = t / nkt;
    const int k0 = kt * 64, n0 = nt * 64;
    const int nn = tid & 63, kr = tid >> 6;
    const float* src; int col;
    if (mode) { src = ((nt & 3) < 2) ? sa : sb; col = (nt >> 2) * 128 + (nt & 1) * 64 + nn; }
    else      { src = sa; col = n0 + nn; }
    const bool ok = col < N;
#pragma unroll
    for (int i = 0; i < 16; i++) {
      const int kk = i * 4 + kr;
      tl[kk * 65 + nn] = ok ? src[(long)(k0 + kk) * N + col] : 0.f;
    }
    __syncthreads();
    const int n2 = tid >> 2, kq = (tid & 3) * 16;
    unsigned wv[8];
#pragma unroll
    for (int j = 0; j < 8; j++) wv[j] = pack2(tl[(kq + 2 * j) * 65 + n2], tl[(kq + 2 * j + 1) * 65 + n2]);
    uint4* dp = (uint4*)(dst + (long)(n0 + n2) * K + k0 + kq);
    dp[0] = make_uint4(wv[0], wv[1], wv[2], wv[3]);
    dp[1] = make_uint4(wv[4], wv[5], wv[6], wv[7]);
    __syncthreads();
  }
}

DI void phase_rope_table(const Params& p) {
  float2* tab = (float2*)(p.ws + OFF_ROPE);
  for (int i = blockIdx.x * NTHR + tidx(); i < 16384 * 16; i += gridDim.x * NTHR) {
    const int pos = i >> 4, j = i & 15;
    const float freq = exp2f(-(float)j * (13.287712379549449f / 16.f));
    const float ang = (float)pos * freq;
    const double a = (double)ang;
    const double k = rint(a * 0.15915494309189535);
    const float rf = (float)(a - k * 6.283185307179586);
    tab[i] = make_float2(__cosf(rf), __sinf(rf));
  }
}

DI void phase_rms_first(const float* __restrict__ x, const float* __restrict__ g, bf16_t* __restrict__ h) {
  const int lane = tidx() & 63, w = tidx() >> 6;
  for (int row = blockIdx.x * 8 + w; row < T_; row += gridDim.x * 8) {
    const float4* xr = (const float4*)(x + (long)row * 1024);
    float4 v[4]; float ss = 0.f;
#pragma unroll
    for (int i = 0; i < 4; i++) { v[i] = xr[lane + i * 64]; ss += v[i].x * v[i].x + v[i].y * v[i].y + v[i].z * v[i].z + v[i].w * v[i].w; }
    ss = wave_sum(ss);
    const float r = rsqrtf(ss * (1.f / 1024.f) + 1e-6f);
    uint2* hr = (uint2*)(h + (long)row * 1024);
#pragma unroll
    for (int i = 0; i < 4; i++) {
      const float4 gg = ((const float4*)g)[lane + i * 64];
      hr[lane + i * 64] = make_uint2(pack2(v[i].x * r * gg.x, v[i].y * r * gg.y), pack2(v[i].z * r * gg.z, v[i].w * r * gg.w));
    }
  }
}

DI void phase_resid(const float* xin, float* xout, bf16_t* yh, const float* __restrict__ gpost, const float* __restrict__ gnext) {
  const int lane = tidx() & 63, w = tidx() >> 6;
  for (int row = blockIdx.x * 8 + w; row < T_; row += gridDim.x * 8) {
    uint2* yr = (uint2*)(yh + (long)row * 1024);
    const float4* xr = (const float4*)(xin + (long)row * 1024);
    float4* xo = (float4*)(xout + (long)row * 1024);
    float4 y[4]; float ss = 0.f;
#pragma unroll
    for (int i = 0; i < 4; i++) {
      const uint2 u = yr[lane + i * 64];
      y[i] = make_float4(bflo(u.x), bfhi(u.x), bflo(u.y), bfhi(u.y));
      ss += y[i].x * y[i].x + y[i].y * y[i].y + y[i].z * y[i].z + y[i].w * y[i].w;
    }
    ss = wave_sum(ss);
    const float r1 = rsqrtf(ss * (1.f / 1024.f) + 1e-6f);
    float ss2 = 0.f;
#pragma unroll
    for (int i = 0; i < 4; i++) {
      const float4 gg = ((const float4*)gpost)[lane + i * 64];
      const float4 xv = xr[lane + i * 64];
      y[i].x = xv.x + y[i].x * r1 * gg.x; y[i].y = xv.y + y[i].y * r1 * gg.y;
      y[i].z = xv.z + y[i].z * r1 * gg.z; y[i].w = xv.w + y[i].w * r1 * gg.w;
      xo[lane + i * 64] = y[i];
      ss2 += y[i].x * y[i].x + y[i].y * y[i].y + y[i].z * y[i].z + y[i].w * y[i].w;
    }
    if (gnext) {
      ss2 = wave_sum(ss2);
      const float r2 = rsqrtf(ss2 * (1.f / 1024.f) + 1e-6f);
#pragma unroll
      for (int i = 0; i < 4; i++) {
        const float4 gg = ((const float4*)gnext)[lane + i * 64];
        yr[lane + i * 64] = make_uint2(pack2(y[i].x * r2 * gg.x, y[i].y * r2 * gg.y), pack2(y[i].z * r2 * gg.z, y[i].w * r2 * gg.w));
      }
    }
  }
}

namespace pg8 {
#define PG8_LAS __attribute__((address_space(3)))
typedef unsigned short bf16_t;
typedef short bf16x8 __attribute__((ext_vector_type(8)));
typedef float f32x4 __attribute__((ext_vector_type(4)));
typedef unsigned u32x4 __attribute__((ext_vector_type(4)));
constexpr int BM = 256, BK = 64, HALF = 128, HTB = HALF * BK * 2  , STAGE_BYTES = 8 * HTB, NXCD = 8, WGM = 8;

__host__ __device__ __forceinline__ int lds_byte(int r, int c) { const int st = (r >> 4) * 2 + (c >> 5), rr = r & 15, cc = c & 31, ob = rr * 64 + cc * 2; return st * 1024 + (ob ^ (((ob >> 9) & 1) << 5)); }
__host__ __device__ __forceinline__ void stage_rc(int b, int& R, int& C) { const int st = b / 1024, sb = b % 1024, swz = sb ^ (((sb >> 9) & 1) << 5); R = (st >> 1) * 16 + swz / 64; C = (st & 1) * 32 + (swz % 64) / 2; }
__host__ __device__ __forceinline__ int perm32(int rho) { const int n = rho >> 4, i = rho & 15; return 8 * (i >> 2) + 4 * n + (i & 3); }

struct Unit { int pm, pn; };
struct Gemm { const bf16_t* A; const bf16_t* Bt; int M, N, K; };

struct StaticOrder {
    int nM, nN, nwg, G, c;
    __host__ __device__ void init(int M, int N, int G_, int c_) { nM = M / BM; nN = N / BM; nwg = nM * nN; G = G_; c = c_; }
    __host__ __device__ bool next(int i, Unit& u) const {
        const long L = (long)i * G + c; if (L >= nwg) return false;
        int wgid = (int)L; { const int q = nwg / NXCD, r = nwg % NXCD, xcd = wgid % NXCD, off = wgid / NXCD; wgid = (xcd < r ? xcd * (q + 1) : r * (q + 1) + (xcd - r) * q) + off; }
        const int nig = WGM * nN, gid = wgid / nig, fm = gid * WGM, gsz = (nM - fm) < WGM ? (nM - fm) : WGM;
        u.pm = fm + ((wgid % nig) % gsz); u.pn = (wgid % nig) / gsz; return true;
    }
    __device__ __forceinline__ void a_ready(const Unit&) const {}
    __device__ __forceinline__ void done(const Unit&) const {}
};
__device__ __forceinline__ unsigned cvt_pk_bf16(float lo, float hi) { unsigned r; asm volatile("v_cvt_pk_bf16_f32 %0, %1, %2" : "=v"(r) : "v"(lo), "v"(hi)); return r; }
typedef float f32x2 __attribute__((ext_vector_type(2)));

struct EpiStoreP {
    static constexpr bool PERM = true, AFTER_DRAIN = false;
    bf16_t* O; int ldc; int nvalid;
    __device__ __forceinline__ void operator()(const f32x4 (&acc)[2][2][4][2], const Unit& u, int wr, int wc, int fr, int fq) const {
        const int row0 = u.pm * BM + wr * 64 + fr, col0 = u.pn * BM + wc * 32 + 8 * fq;
#pragma unroll
        for (int ai = 0; ai < 2; ++ai)
#pragma unroll
            for (int m = 0; m < 4; ++m) { bf16_t* rowp = O + (size_t)(row0 + ai * HALF + m * 16) * ldc + col0;
#pragma unroll
                for (int bj = 0; bj < 2; ++bj) if (col0 + bj * HALF < nvalid) {
                    const f32x4 v0 = acc[ai][bj][m][0], v1 = acc[ai][bj][m][1];
                    u32x4 w; w.x = cvt_pk_bf16(v0[0], v0[1]); w.y = cvt_pk_bf16(v0[2], v0[3]); w.z = cvt_pk_bf16(v1[0], v1[1]); w.w = cvt_pk_bf16(v1[2], v1[3]);
                    *(u32x4*)(rowp + bj * HALF) = w; } }
    }
};
struct EpiSwigluP {
    static constexpr bool PERM = true, AFTER_DRAIN = false;
    bf16_t* O;
    static __device__ __forceinline__ float sg(float g, float uu) { return g * __builtin_amdgcn_rcpf(1.f + __expf(-g)) * uu; }
    __device__ __forceinline__ void operator()(const f32x4 (&acc)[2][2][4][2], const Unit& u, int wr, int wc, int fr, int fq) const {
        const int row0 = u.pm * BM + wr * 64 + fr, col0 = u.pn * HALF + wc * 32 + 8 * fq;
#pragma unroll
        for (int ai = 0; ai < 2; ++ai)
#pragma unroll
            for (int m = 0; m < 4; ++m) {
                const f32x4 g0 = acc[ai][0][m][0], g1 = acc[ai][0][m][1], u0 = acc[ai][1][m][0], u1 = acc[ai][1][m][1];
                u32x4 w; w.x = cvt_pk_bf16(sg(g0[0], u0[0]), sg(g0[1], u0[1])); w.y = cvt_pk_bf16(sg(g0[2], u0[2]), sg(g0[3], u0[3]));
                w.z = cvt_pk_bf16(sg(g1[0], u1[0]), sg(g1[1], u1[1])); w.w = cvt_pk_bf16(sg(g1[2], u1[2]), sg(g1[3], u1[3]));
                *(u32x4*)(O + (size_t)(row0 + ai * HALF + m * 16) * 2816 + col0) = w; }
    }
};
template <class Epi, class Sched, bool STAMP = false>
__device__ __forceinline__ void gemm_phase(PG8_LAS unsigned char* lds, const Gemm g, const Sched& S, const Epi& E, unsigned long long* stamps) {
    int tid = threadIdx.x; asm volatile("" : "+v"(tid));
    const int wid = __builtin_amdgcn_readfirstlane(tid >> 6), lane = tid & 63, wr = wid >> 2, wc = wid & 3, fr = lane & 15, fq = lane >> 4;
    const int K = g.K, nt = K / BK;
    int ts_lo = 0, ts_hi = 0, nts = 0; const unsigned long long rt_entry = STAMP ? (unsigned long long)wall_clock64() : 0ull;
#define PG8_STAMP() do { if (STAMP && wid == 0 && nts < 64) { const unsigned long long _c = (unsigned long long)clock64(); \
        ts_lo = (lane == nts) ? (int)(unsigned)_c : ts_lo; ts_hi = (lane == nts) ? (int)(unsigned)(_c >> 32) : ts_hi; ++nts; } } while (0)
    PG8_STAMP();
    unsigned voffA[2], voffB[2];
#pragma unroll
    for (int i = 0; i < 2; ++i) { int R, C; stage_rc(tid * 16 + i * 8192, R, C); const int Rb = Epi::PERM ? ((R & ~31) + perm32(R & 31)) : R;
        voffA[i] = (unsigned)(R * K + C) * 2u; voffB[i] = (unsigned)(Rb * K + C) * 2u; }
    const size_t kstep = (size_t)(BK * 2);
    const size_t hstep = (size_t)HALF * K * 2;
    const size_t tstep = 2 * hstep;
    const unsigned ldsw = (unsigned)wid * 1024u;
    const int aoff = lds_byte(wr * 64 + fr, fq * 8), boff = lds_byte(wc * 32 + fr, fq * 8);
#define PG8_SA(b, h) (((b) * 2 + (h)) * HTB)
#define PG8_SB(b, h) ((4 + (b) * 2 + (h)) * HTB)
#define PG8_STAGE(bufoff, gbase, voff) do { _Pragma("unroll") for (int _i = 0; _i < 2; ++_i) \
        __builtin_amdgcn_global_load_lds((const unsigned*)((const char*)(gbase) + (voff)[_i]), (PG8_LAS unsigned*)(lds + (bufoff) + ldsw + _i * 8192), 16, 0, 0); } while (0)
#define PG8_LDA(dst, b, h) do { _Pragma("unroll") for (int m = 0; m < 4; ++m) _Pragma("unroll") for (int k = 0; k < 2; ++k) dst[m][k] = *(const PG8_LAS bf16x8*)(lds + PG8_SA(b, h) + aoff + m * 2048 + k * 1024); } while (0)
#define PG8_LDB(dst, b, h) do { _Pragma("unroll") for (int n = 0; n < 2; ++n) _Pragma("unroll") for (int k = 0; k < 2; ++k) dst[n][k] = *(const PG8_LAS bf16x8*)(lds + PG8_SB(b, h) + boff + n * 2048 + k * 1024); } while (0)
#define PG8_MMA(ai, bj, At, Bt) do { __builtin_amdgcn_s_setprio(1); _Pragma("unroll") for (int m = 0; m < 4; ++m) _Pragma("unroll") for (int n = 0; n < 2; ++n) _Pragma("unroll") for (int k = 0; k < 2; ++k) \
        acc[ai][bj][m][n] = __builtin_amdgcn_mfma_f32_16x16x32_bf16(Bt[n][k], At[m][k], acc[ai][bj][m][n], 0, 0, 0); __builtin_amdgcn_s_setprio(0); } while (0)
#define PG8_WAIT_V(n) asm volatile("s_waitcnt vmcnt(" #n ")" ::: "memory")
#define PG8_WAIT_L(n) asm volatile("s_waitcnt lgkmcnt(" #n ")" ::: "memory")
#define PG8_BAR __builtin_amdgcn_s_barrier()
#define PG8_SCHED __builtin_amdgcn_sched_barrier(0)
    Unit cur, nxt; int ui = 0;
    if (!S.next(0, cur)) return;
    f32x4 acc[2][2][4][2];
#pragma unroll
    for (int a = 0; a < 2; ++a)
#pragma unroll
        for (int b = 0; b < 2; ++b)
#pragma unroll
            for (int m = 0; m < 4; ++m)
#pragma unroll
                for (int n = 0; n < 2; ++n) acc[a][b][m][n] = (f32x4){0.f, 0.f, 0.f, 0.f};
    bf16x8 At[4][2], B0[2][2], B1[2][2];
    const char* cA = (const char*)g.A + (size_t)cur.pm * tstep; const char* cB = (const char*)g.Bt + (size_t)cur.pn * tstep;
    S.a_ready(cur);
    PG8_STAGE(PG8_SB(0, 0), cB, voffB); PG8_STAGE(PG8_SA(0, 0), cA, voffA); PG8_STAGE(PG8_SB(0, 1), cB + hstep, voffB); PG8_STAGE(PG8_SA(0, 1), cA + hstep, voffA);
    if (wr == 1) PG8_BAR;
    PG8_WAIT_V(4); PG8_BAR;
    PG8_STAGE(PG8_SB(1, 0), cB + kstep, voffB); PG8_STAGE(PG8_SA(1, 0), cA + kstep, voffA); PG8_STAGE(PG8_SB(1, 1), cB + hstep + kstep, voffB);
    PG8_WAIT_V(6); PG8_BAR;
    PG8_STAMP();
    for (;;) {
        const bool has_next = S.next(ui + 1, nxt);
        const char* nA = has_next ? (const char*)g.A + (size_t)nxt.pm * tstep : cA; const char* nB = has_next ? (const char*)g.Bt + (size_t)nxt.pn * tstep : cB;
        for (int t = 0; t < nt; t += 2) {
            const bool last = (t == nt - 2);
            const char* a1 = cA + (size_t)(t + 1) * kstep;
            const char* a2 = last ? nA : cA + (size_t)(t + 2) * kstep; const char* b2 = last ? nB : cB + (size_t)(t + 2) * kstep;
            const char* a3 = a2 + kstep; const char* b3 = b2 + kstep;
            if (last && has_next) S.a_ready(nxt);
            PG8_LDB(B0, 0, 0); PG8_SCHED; PG8_LDA(At, 0, 0); PG8_STAGE(PG8_SA(1, 1), a1 + hstep, voffA);
            PG8_WAIT_L(8); PG8_BAR; PG8_WAIT_L(0); PG8_MMA(0, 0, At, B0); PG8_BAR; PG8_SCHED;
            PG8_LDB(B1, 0, 1); PG8_STAGE(PG8_SB(0, 0), b2, voffB);
            PG8_BAR; PG8_WAIT_L(0); PG8_MMA(0, 1, At, B1); PG8_BAR;
            PG8_LDA(At, 0, 1); PG8_STAGE(PG8_SA(0, 0), a2, voffA);
            PG8_BAR; PG8_WAIT_L(0); PG8_MMA(1, 0, At, B0); PG8_BAR; PG8_SCHED;
            PG8_STAGE(PG8_SB(0, 1), b2 + hstep, voffB);
            PG8_WAIT_V(6); PG8_BAR; PG8_MMA(1, 1, At, B1); PG8_BAR;
            PG8_LDB(B0, 1, 0); PG8_SCHED; PG8_LDA(At, 1, 0); PG8_STAGE(PG8_SA(0, 1), a2 + hstep, voffA);
            PG8_WAIT_L(8); PG8_BAR; PG8_WAIT_L(0); PG8_MMA(0, 0, At, B0); PG8_BAR; PG8_SCHED;
            PG8_LDB(B1, 1, 1); PG8_STAGE(PG8_SB(1, 0), b3, voffB);
            PG8_BAR; PG8_WAIT_L(0); PG8_MMA(0, 1, At, B1); PG8_BAR;
            PG8_LDA(At, 1, 1); PG8_STAGE(PG8_SA(1, 0), a3, voffA);
            PG8_BAR; PG8_WAIT_L(0); PG8_MMA(1, 0, At, B0); PG8_BAR; PG8_SCHED;
            PG8_STAGE(PG8_SB(1, 1), b3 + hstep, voffB);
            PG8_WAIT_V(6); PG8_BAR; PG8_MMA(1, 1, At, B1); PG8_BAR;
        }
        PG8_STAMP();
        if constexpr (!Epi::AFTER_DRAIN) { E(acc, cur, wr, wc, fr, fq); S.done(cur); }
        PG8_STAMP();
        if (!has_next) break;
#pragma unroll
        for (int a = 0; a < 2; ++a)
#pragma unroll
            for (int b = 0; b < 2; ++b)
#pragma unroll
                for (int m = 0; m < 4; ++m)
#pragma unroll
                    for (int n = 0; n < 2; ++n) acc[a][b][m][n] = (f32x4){0.f, 0.f, 0.f, 0.f};
        cur = nxt; cA = nA; cB = nB; ++ui;
    }
    PG8_WAIT_V(0);
    if (wr == 0) PG8_BAR;
    PG8_BAR;
    if constexpr (Epi::AFTER_DRAIN) { E.fused(acc, cur, wr, wc, fr, fq, lds, wid, lane); S.done(cur); }
    PG8_STAMP();
    if (STAMP && wid == 0) { stamps[lane] = lane < nts ? (((unsigned long long)(unsigned)ts_hi << 32) | (unsigned)ts_lo) : 0ull;
        if (lane == 62) stamps[62] = rt_entry; if (lane == 63) stamps[63] = (unsigned long long)wall_clock64(); }
#undef PG8_STAMP
#undef PG8_SA
#undef PG8_SB
#undef PG8_STAGE
#undef PG8_LDA
#undef PG8_LDB
#undef PG8_MMA
#undef PG8_WAIT_V
#undef PG8_WAIT_L
#undef PG8_BAR
#undef PG8_SCHED
}
}

#include <cstdio>
#include <ctime>
#include <cstdlib>
#include <cstring>
#include <cmath>
#include <vector>
#include <algorithm>

template <class Epi>
DI void phase_gemm(const bf16_t* A, const bf16_t* Bt, int N, int K, char* smem, const Epi& epi) {
  pg8::StaticOrder so;
  so.init(T_, N, (int)gridDim.x, (int)blockIdx.x);
  pg8::gemm_phase((PG8_LAS unsigned char*)smem, pg8::Gemm{A, Bt, T_, N, K}, so, epi, (unsigned long long*)nullptr);
}

template <int DQK>
DI void attn_qk(const bf16_t* Ks, const bf16x8 (&qf)[DQK / 16], f32x16 (&s)[2], int l31, int hh) {
  bf16x8 kf[2][DQK / 16];
#pragma unroll
  for (int ks = 0; ks < DQK / 16; ks++)
#pragma unroll
    for (int kb = 0; kb < 2; kb++) kf[kb][ks] = lds_frag(Ks, DQK + 8, kb * 32, ks * 16, l31, hh);
#pragma unroll
  for (int kb = 0; kb < 2; kb++)
#pragma unroll
    for (int r = 0; r < 16; r++) s[kb][r] = 0.f;
#pragma unroll
  for (int ks = 0; ks < DQK / 16; ks++)
#pragma unroll
    for (int kb = 0; kb < 2; kb++) s[kb] = MFMA32(kf[kb][ks], qf[ks], s[kb]);
}
#define ATT_V_LOAD(VS_)                                                                                       \
  {                                                                                                           \
    _Pragma("unroll") for (int kb_ = 0; kb_ < 2; kb_++)                                                       \
    _Pragma("unroll") for (int st_ = 0; st_ < 2; st_++)                                                       \
    _Pragma("unroll") for (int mb_ = 0; mb_ < 2; mb_++) {                                                     \
      const bf16_t* base_ = (VS_) + (kb_ * 32 + 16 * st_ + 4 * hh + q4) * 72 + mb_ * 32 + 16 * blk + 4 * p4;  \
      const s16x4 lo_ = tr_read(base_);                                                                       \
      const s16x4 hi_ = tr_read(base_ + 8 * 72);                                                              \
      vf[(kb_ * 2 + st_) * 2 + mb_] = __builtin_shufflevector(lo_, hi_, 0, 1, 2, 3, 4, 5, 6, 7);              \
    }                                                                                                         \
  }
#define ATT_PV_MMA()                                                   \
  {                                                                    \
    o[0] = MFMA32(vf[0], pb0, o[0]); o[1] = MFMA32(vf[1], pb0, o[1]);  \
    o[0] = MFMA32(vf[2], pb1, o[0]); o[1] = MFMA32(vf[3], pb1, o[1]);  \
    o[0] = MFMA32(vf[4], pb2, o[0]); o[1] = MFMA32(vf[5], pb2, o[1]);  \
    o[0] = MFMA32(vf[6], pb3, o[0]); o[1] = MFMA32(vf[7], pb3, o[1]);  \
  }
template <int MODE>
DI float attn_sm_max(f32x16 (&s)[2], f32x16 (&o)[2], float& m, float& l, int lim, int win, float sc, float slope2, int hh) {
  float mx = -INFINITY;
  if (MODE == 0) {
#pragma unroll
    for (int kb = 0; kb < 2; kb++)
#pragma unroll
      for (int r = 0; r < 16; r++) mx = fmaxf(mx, s[kb][r]);
    mx *= sc;
  } else if (MODE == 1) {
#pragma unroll
    for (int kb = 0; kb < 2; kb++)
#pragma unroll
      for (int r = 0; r < 16; r++) {
        const float v = (kb * 32 + crow(r, hh) <= lim) ? s[kb][r] : -INFINITY;
        s[kb][r] = v; mx = fmaxf(mx, v);
      }
    mx *= sc;
  } else {
#pragma unroll
    for (int kb = 0; kb < 2; kb++)
#pragma unroll
      for (int r = 0; r < 16; r++) {
        const int rel = lim - (kb * 32 + crow(r, hh));
        float v = s[kb][r] * sc - slope2 * (float)rel;
        v = ((unsigned)rel <= (unsigned)win) ? v : -INFINITY;
        s[kb][r] = v; mx = fmaxf(mx, v);
      }
  }
  mx = fmaxf(mx, __shfl_xor(mx, 32));
  const float mn = fmaxf(m, mx);
  if (__builtin_amdgcn_ballot_w64(mn > m) != 0) {
    const float alpha = ex2(m - mn);
    l *= alpha;
#pragma unroll
    for (int mb = 0; mb < 2; mb++)
#pragma unroll
      for (int r = 0; r < 16; r++) o[mb][r] *= alpha;
  }
  m = mn;
  return -mn;
}
template <int MODE>
DI void attn_sm_exp(f32x16 (&s)[2], float& l, float sc, float negb, bf16x8& pb0, bf16x8& pb1, bf16x8& pb2, bf16x8& pb3) {
  float rs = 0.f;
#pragma unroll
  for (int kb = 0; kb < 2; kb++)
#pragma unroll
    for (int r = 0; r < 16; r++) {
      const float pv = (MODE == 2) ? ex2(s[kb][r] + negb) : ex2(__builtin_fmaf(s[kb][r], sc, negb));
      s[kb][r] = pv; rs += pv;
    }
  rs += __shfl_xor(rs, 32);
  l += rs;
  pb0 = pack8(s[0][0], s[0][1], s[0][2], s[0][3], s[0][4], s[0][5], s[0][6], s[0][7]);
  pb1 = pack8(s[0][8], s[0][9], s[0][10], s[0][11], s[0][12], s[0][13], s[0][14], s[0][15]);
  pb2 = pack8(s[1][0], s[1][1], s[1][2], s[1][3], s[1][4], s[1][5], s[1][6], s[1][7]);
  pb3 = pack8(s[1][8], s[1][9], s[1][10], s[1][11], s[1][12], s[1][13], s[1][14], s[1][15]);
}
template <int MODE>
DI void attn_softmax(f32x16 (&s)[2], f32x16 (&o)[2], float& m, float& l, int lim, int win, float sc, float slope2, int hh,
                     bf16x8& pb0, bf16x8& pb1, bf16x8& pb2, bf16x8& pb3) {
  const float negb = attn_sm_max<MODE>(s, o, m, l, lim, win, sc, slope2, hh);
  attn_sm_exp<MODE>(s, l, sc, negb, pb0, pb1, pb2, pb3);
}

template <int DQK, bool WINDOWED>
DI void attn_tile(char* smem, const bf16_t* __restrict__ qp, int q_ld, const bf16_t* __restrict__ kp, int k_ld,
                  const bf16_t* __restrict__ k2p, int k2_ld, const bf16_t* __restrict__ vp, int v_ld,
                  long tok_base, int tok_stride, int q0, int kv_lo, int kv_hi, int win, float scale2, float slope2,
                  int mode, float sink2, float* st_o, float* st_ml, int st_h, bf16_t* outp, int out_ld, const float2* __restrict__ qrope) {
  constexpr int KS = DQK + 8, VS = 72, NKS = DQK / 16, CPR = DQK / 8;
  constexpr int STG = 64 * KS + 64 * VS;
  bf16_t* ring = (bf16_t*)smem;
  const int tid = tidx(), lane = tid & 63, w = tid >> 6, l31 = lane & 31, hh = lane >> 5;
  const int qi = q0 + w * 32 + l31;
  const long qtok = tok_base + (long)qi * tok_stride;
  bf16x8 qf[NKS];
#pragma unroll
  for (int ks = 0; ks < NKS; ks++) qf[ks] = *(const bf16x8*)(qp + qtok * q_ld + ks * 16 + hh * 8);
  if (DQK == 96) {
    const float2* tp = qrope + (qtok & (S_ - 1)) * 16 + hh * 8;
    float r1[8], r2[8];
#pragma unroll
    for (int i = 0; i < 8; i++) {
      const float2 cs = tp[i];
      const float t1 = bf2f((bf16_t)qf[NKS - 2][i]), t2 = bf2f((bf16_t)qf[NKS - 1][i]);
      r1[i] = t1 * cs.x - t2 * cs.y; r2[i] = t2 * cs.x + t1 * cs.y;
    }
    qf[NKS - 2] = pack8(r1[0], r1[1], r1[2], r1[3], r1[4], r1[5], r1[6], r1[7]);
    qf[NKS - 1] = pack8(r2[0], r2[1], r2[2], r2[3], r2[4], r2[5], r2[6], r2[7]);
  }
  f32x16 o[2];
  float m = -1e30f, l = 0.f;
  if (mode == 2 || mode == 3) {
#pragma unroll
    for (int mb = 0; mb < 2; mb++)
#pragma unroll
      for (int g = 0; g < 4; g++) {
        const float4 v = *(const float4*)(st_o + qtok * 512 + st_h * 64 + mb * 32 + 8 * g + 4 * hh);
        o[mb][4 * g + 0] = v.x; o[mb][4 * g + 1] = v.y; o[mb][4 * g + 2] = v.z; o[mb][4 * g + 3] = v.w;
      }
    m = st_ml[qtok * 8 + st_h];
    l = st_ml[(long)T_ * 8 + qtok * 8 + st_h];
  } else {
#pragma unroll
    for (int mb = 0; mb < 2; mb++)
#pragma unroll
      for (int r = 0; r < 16; r++) o[mb][r] = 0.f;
  }
  const int q_lo = q0 + w * 32, q_hi = q_lo + 31;
  const int q4 = (lane & 15) >> 2, p4 = lane & 3, blk = (lane >> 4) & 1;
  bf16x8 pb0 = qf[0], pb1 = qf[0], pb2 = qf[0], pb3 = qf[0];
  bf16x8 vf[8];

  const int kr0 = tid / CPR, kc0 = tid % CPR;
  const int kr1 = (tid + 512) / CPR, kc1 = (tid + 512) % CPR;
  const int vr = tid >> 3, vc = tid & 7;
  uint4 rk0, rk1 = make_uint4(0, 0, 0, 0), rv;
#define ATT_LOAD(KV0)                                                                                          \
  {                                                                                                            \
    const long t0 = tok_base + (long)((KV0) + kr0) * tok_stride;                                               \
    rk0 = (DQK == 96 && kc0 >= 8) ? *(const uint4*)(k2p + t0 * k2_ld + (kc0 - 8) * 8) : *(const uint4*)(kp + t0 * k_ld + kc0 * 8); \
    if (DQK == 96 && tid < 256) {                                                                              \
      const long t1 = tok_base + (long)((KV0) + kr1) * tok_stride;                                             \
      rk1 = (kc1 >= 8) ? *(const uint4*)(k2p + t1 * k2_ld + (kc1 - 8) * 8) : *(const uint4*)(kp + t1 * k_ld + kc1 * 8); \
    }                                                                                                          \
    const long t2 = tok_base + (long)((KV0) + vr) * tok_stride;                                                \
    rv = *(const uint4*)(vp + t2 * v_ld + vc * 8);                                                             \
  }
#define ATT_STORE(STAGE)                                                                      \
  {                                                                                           \
    bf16_t* ks_ = ring + (STAGE) * STG; bf16_t* vs_ = ks_ + 64 * KS;                          \
    *(uint4*)(ks_ + kr0 * KS + kc0 * 8) = rk0;                                                \
    if (DQK == 96 && tid < 256) *(uint4*)(ks_ + kr1 * KS + kc1 * 8) = rk1;                    \
    *(uint4*)(vs_ + vr * VS + vc * 8) = rv;                                                   \
  }
#define ATT_ACTIVE(KV0) (WINDOWED ? !((KV0) > q_hi || (KV0) + 63 < q_lo - win) : !((KV0) > q_hi))
  __syncthreads();
  ATT_LOAD(kv_lo)
  ATT_STORE(0)
  if (kv_lo + 64 < kv_hi) { ATT_LOAD(kv_lo + 64) ATT_STORE(1) }
  if (kv_lo + 128 < kv_hi) ATT_LOAD(kv_lo + 128)
  __syncthreads();
  f32x16 s[2];
  if (ATT_ACTIVE(kv_lo)) attn_qk<DQK>(ring, qf, s, l31, hh);
  int stage = 0;
  for (int kv0 = kv_lo; kv0 < kv_hi; kv0 += 64) {
    const int st1 = (stage == 2) ? 0 : stage + 1;
    const int st2 = (st1 == 2) ? 0 : st1 + 1;
    if (kv0 + 128 < kv_hi) ATT_STORE(st2)
    if (kv0 + 192 < kv_hi) ATT_LOAD(kv0 + 192)
    __builtin_amdgcn_sched_barrier(0);
    const bf16_t* Vs = ring + stage * STG + 64 * KS;
    const bf16_t* Kn = ring + st1 * STG;
    const bool act = ATT_ACTIVE(kv0);
    const bool actn = (kv0 + 64 < kv_hi) && ATT_ACTIVE(kv0 + 64);
    const int lim = qi - kv0;
    if (!WINDOWED && act && actn) {
      ATT_V_LOAD(Vs)
      const float negb = attn_sm_max<0>(s, o, m, l, lim, win, scale2, slope2, hh);
      f32x16 sn[2];
      attn_qk<DQK>(Kn, qf, sn, l31, hh);
      attn_sm_exp<0>(s, l, scale2, negb, pb0, pb1, pb2, pb3);
#pragma unroll
      for (int g = 0; g < 2 * NKS; g++) {
        __builtin_amdgcn_sched_group_barrier(0x008, 1, 0);
        __builtin_amdgcn_sched_group_barrier(0x002, 9, 0);
      }
      ATT_PV_MMA()
      s[0] = sn[0]; s[1] = sn[1];
    } else {
      if (act) {
        ATT_V_LOAD(Vs)
        if (WINDOWED) attn_softmax<2>(s, o, m, l, lim, win, scale2, slope2, hh, pb0, pb1, pb2, pb3);
        else if (kv0 + 63 <= q_lo) attn_softmax<0>(s, o, m, l, lim, win, scale2, slope2, hh, pb0, pb1, pb2, pb3);
        else attn_softmax<1>(s, o, m, l, lim, win, scale2, slope2, hh, pb0, pb1, pb2, pb3);
        ATT_PV_MMA()
      }
      if (actn) attn_qk<DQK>(Kn, qf, s, l31, hh);
    }
    __syncthreads();
    stage = st1;
  }
#undef ATT_ACTIVE
#undef ATT_LOAD
#undef ATT_STORE
  if (mode == 1 || mode == 2) {
#pragma unroll
    for (int mb = 0; mb < 2; mb++)
#pragma unroll
      for (int g = 0; g < 4; g++)
        *(float4*)(st_o + qtok * 512 + st_h * 64 + mb * 32 + 8 * g + 4 * hh) =
            make_float4(o[mb][4 * g + 0], o[mb][4 * g + 1], o[mb][4 * g + 2], o[mb][4 * g + 3]);
    if (hh == 0) { st_ml[qtok * 8 + st_h] = m; st_ml[(long)T_ * 8 + qtok * 8 + st_h] = l; }
  } else {
    float mult;
    if (mode == 4) {
      const float mf = fmaxf(m, sink2);
      const float a = ex2(m - mf);
      mult = a * rcpf(l * a + ex2(sink2 - mf));
    } else {
      mult = rcpf(l);
    }
#pragma unroll
    for (int mb = 0; mb < 2; mb++)
#pragma unroll
      for (int g = 0; g < 4; g++)
        *(uint2*)(outp + qtok * out_ld + mb * 32 + 8 * g + 4 * hh) =
            make_uint2(pack2(o[mb][4 * g + 0] * mult, o[mb][4 * g + 1] * mult), pack2(o[mb][4 * g + 2] * mult, o[mb][4 * g + 3] * mult));
  }
}

DI void attnA_task(const Params& p, char* smem, int tau, int pat) {
  const int dil = (pat == 0) ? 1 : (pat == 1 ? 4 : 16);
  const int ntile = (S_ / dil) >> 8;
  const int bh = tau >> 6, rem = tau & 63;
  const int r = rem / ntile, n = rem % ntile;
  const int b = bh >> 3, h = bh & 7;
  const bf16_t* pj = (const bf16_t*)(p.ws + OFF_BIG);
  const int q0 = n * 256;
  const int kv_lo = (q0 >= 128) ? q0 - 128 : 0;
  const float slope2 = exp2f(-(float)(h + 1)) * (float)dil * LOG2E;
  const int mode = (pat == 0) ? 1 : (pat == 1 ? 2 : 3);
  attn_tile<64, true>(smem, pj + h * 64, 3088, pj + 512 + h * 64, 3088, nullptr, 0, pj + 1024 + h * 64, 3088,
                (long)b * S_ + r, dil, q0, kv_lo, q0 + 256, 128, 0.125f * LOG2E, slope2, mode, 0.f,
                (float*)(p.ws + OFF_HBUF), (float*)(p.ws + OFF_ML), h,
                (bf16_t*)(p.ws + OFF_MIX) + h * 64, 1024, nullptr);
}

DI void attnC_task(const Params& p, char* smem, int tau) {
  const int b = tau >> 9, hq = (tau >> 6) & 7, tile = tau & 63;
  const int kvh = hq >> 2;
  const bf16_t* pj = (const bf16_t*)(p.ws + OFF_P1);
  const int q0 = tile * 256;
  const int kv_lo = (q0 >= 128) ? q0 - 128 : 0;
  attn_tile<64, true>(smem, pj + hq * 64, 1440, pj + 512 + kvh * 64, 1440, nullptr, 0, pj + 640 + kvh * 64, 1440,
                (long)b * S_, 1, q0, kv_lo, q0 + 256, 127, 0.125f * LOG2E, exp2f(-(float)(hq + 1)) * LOG2E, 4,
                p.sinks[hq] * LOG2E, nullptr, nullptr, 0, (bf16_t*)(p.ws + OFF_MIX) + hq * 64, 1024, nullptr);
}

DI void attnD_task(const Params& p, char* smem, int tau) {
  const int bh = tau >> 5, i = tau & 31;
  const int b = bh >> 3, h = bh & 7;
  const bf16_t* qb = (const bf16_t*)(p.ws + OFF_Q);
  const bf16_t* kv = (const bf16_t*)(p.ws + OFF_KV);
  const bf16_t* kpe = (const bf16_t*)(p.ws + OFF_KPE);
  const float scale2 = 0.10206207261596575f * LOG2E;
#pragma unroll 1
  for (int u = 0; u < 2; u++) {
    const int tile = u ? i : (63 - i);
    const int q0 = tile * 256;
    attn_tile<96, false>(smem, qb + h * 96, 768, kv + h * 128, 1024, kpe, 32, kv + h * 128 + 64, 1024,
                  (long)b * S_, 1, q0, 0, q0 + 256, 1 << 30, scale2, 0.f, 0, 0.f, nullptr, nullptr, 0,
                  (bf16_t*)(p.ws + OFF_MIX) + 512 + h * 64, 1024, (const float2*)(p.ws + OFF_ROPE));
  }
}

DI void gla_gate(const Params& p, float* bc, long tok0, int h, int tid) {
  const bf16_t* pj = (const bf16_t*)(p.ws + OFF_BIG);
  const int d = tid & 63, sg = tid >> 6;
  float wc[16];
#pragma unroll
  for (int r = 0; r < 16; r++) wc[r] = p.gla_wg[r * 256 + h * 64 + d];
  const float bias = p.gla_bg[h * 64 + d];
#pragma unroll 1
  for (int i = 0; i < 16; i++) {
    const int s = sg * 16 + i;
    const uint4* gp = (const uint4*)(pj + (tok0 + s) * 3088 + 3072);
    const uint4 g0 = gp[0], g1 = gp[1];
    float x = bias;
    x += bflo(g0.x) * wc[0] + bfhi(g0.x) * wc[1] + bflo(g0.y) * wc[2] + bfhi(g0.y) * wc[3];
    x += bflo(g0.z) * wc[4] + bfhi(g0.z) * wc[5] + bflo(g0.w) * wc[6] + bfhi(g0.w) * wc[7];
    x += bflo(g1.x) * wc[8] + bfhi(g1.x) * wc[9] + bflo(g1.y) * wc[10] + bfhi(g1.y) * wc[11];
    x += bflo(g1.z) * wc[12] + bfhi(g1.z) * wc[13] + bflo(g1.w) * wc[14] + bfhi(g1.w) * wc[15];
    const float ls = fminf(x, 0.f) - __logf(1.f + __expf(-fabsf(x)));
    bc[s * 64 + d] = ls * (1.f / 16.f);
  }
  __syncthreads();
  if (tid < 64) {
    float c = 0.f;
#pragma unroll 8
    for (int s = 0; s < 64; s++) { c += bc[s * 64 + tid]; bc[s * 64 + tid] = c; }
  }
  __syncthreads();
}

DI void gla_stage_vt(const Params& p, bf16_t* Vt, long tok0, int h, int tid) {
  const bf16_t* pj = (const bf16_t*)(p.ws + OFF_BIG);
  const int e = tid & 127, sg2 = tid >> 7;
  unsigned wv[16];
#pragma unroll
  for (int j = 0; j < 16; j++) {
    const unsigned lo = pj[(tok0 + sg2 * 32 + 2 * j) * 3088 + 2048 + h * 128 + e];
    const unsigned hi = pj[(tok0 + sg2 * 32 + 2 * j + 1) * 3088 + 2048 + h * 128 + e];
    wv[j] = lo | (hi << 16);
  }
  uint4* dp = (uint4*)(Vt + e * 72 + sg2 * 32);
  dp[0] = make_uint4(wv[0], wv[1], wv[2], wv[3]);
  dp[1] = make_uint4(wv[4], wv[5], wv[6], wv[7]);
  dp[2] = make_uint4(wv[8], wv[9], wv[10], wv[11]);
  dp[3] = make_uint4(wv[12], wv[13], wv[14], wv[15]);
}

DI void gla_a_task(const Params& p, char* smem, int task) {
  const int tid = tidx() & 255, lane = tid & 63, w = tid >> 6, l31 = lane & 31, hh = lane >> 5;
  smem += (tidx() >> 8) * 73728;
  const int bh = task >> 8, n = task & 255, b = bh >> 2, h = bh & 3;
  const long tok0 = (long)b * S_ + n * 64;
  float* bc = (float*)smem;
  bf16_t* Vt = (bf16_t*)(smem + 34816);
  bf16_t* KdT = (bf16_t*)(smem + 53248);
  const bf16_t* pj = (const bf16_t*)(p.ws + OFF_BIG);
  gla_gate(p, bc, tok0, h, tid);
  {
    const int d = tid & 63, sg = tid >> 6;
    const float bl = bc[63 * 64 + d];
    unsigned wv[8];
#pragma unroll
    for (int j = 0; j < 8; j++) {
      const int s0 = sg * 16 + 2 * j;
      const float k0 = bf2f(pj[(tok0 + s0) * 3088 + 1792 + h * 64 + d]) * __expf(bl - bc[s0 * 64 + d]);
      const float k1 = bf2f(pj[(tok0 + s0 + 1) * 3088 + 1792 + h * 64 + d]) * __expf(bl - bc[(s0 + 1) * 64 + d]);
      wv[j] = pack2(k0, k1);
    }
    uint4* dp = (uint4*)(KdT + d * 72 + sg * 16);
    dp[0] = make_uint4(wv[0], wv[1], wv[2], wv[3]);
    dp[1] = make_uint4(wv[4], wv[5], wv[6], wv[7]);
  }
  gla_stage_vt(p, Vt, tok0, h, tid);
  __syncthreads();
  f32x16 acc[2];
#pragma unroll
  for (int nb = 0; nb < 2; nb++)
#pragma unroll
    for (int r = 0; r < 16; r++) acc[nb][r] = 0.f;
#pragma unroll
  for (int ks = 0; ks < 4; ks++) {
    const bf16x8 a = lds_frag(Vt, 72, w * 32, ks * 16, l31, hh);
#pragma unroll
    for (int nb = 0; nb < 2; nb++) {
      const bf16x8 bb = lds_frag(KdT, 72, nb * 32, ks * 16, l31, hh);
      acc[nb] = MFMA32(a, bb, acc[nb]);
    }
  }
  float* dst = (float*)((char*)p.out + OUT_DST) + (long)task * 8192;
#pragma unroll
  for (int nb = 0; nb < 2; nb++)
#pragma unroll
    for (int r = 0; r < 16; r++) dst[(w * 32 + crow(r, hh)) * 64 + nb * 32 + l31] = acc[nb][r];
  if (tid < 64) ((float*)((char*)p.out + OUT_DEC))[task * 64 + tid] = __expf(bc[63 * 64 + tid]);
  __syncthreads();
}

DI void gla_scan_item(const Params& p, int item) {
  const int idx = item * NTHR + tidx();
  const int bh = idx >> 13, ed = idx & 8191, d = ed & 63;
  const float* dS = (const float*)((char*)p.out + OUT_DST);
  const float* dec = (const float*)((char*)p.out + OUT_DEC);
  bf16_t* sp = (bf16_t*)((char*)p.out + OUT_SPT);
  float st = 0.f;
#pragma unroll 1
  for (int n = 0; n < 256; n += 8) {
    float ds[8], dc[8];
#pragma unroll
    for (int u = 0; u < 8; u++) {
      const long task = bh * 256 + n + u;
      ds[u] = dS[task * 8192 + ed];
      dc[u] = dec[task * 64 + d];
    }
#pragma unroll
    for (int u = 0; u < 8; u++) {
      const long task = bh * 256 + n + u;
      sp[task * 8192 + ed] = f2bf(st);
      st = dc[u] * st + ds[u];
    }
  }
}

DI void gla_c_task(const Params& p, char* smem, int task) {
  const int tid = tidx() & 255, lane = tid & 63, w = tid >> 6, l31 = lane & 31, hh = lane >> 5;
  smem += (tidx() >> 8) * 73728;
  const int bh = task >> 8, n = task & 255, b = bh >> 2, h = bh & 3;
  const long tok0 = (long)b * S_ + n * 64;
  float* bc = (float*)smem;
  bf16_t* att = (bf16_t*)smem;
  bf16_t* Qg = (bf16_t*)(smem + 16384);
  bf16_t* Kg = (bf16_t*)(smem + 25600);
  bf16_t* Vt = (bf16_t*)(smem + 34816);
  bf16_t* SpT = (bf16_t*)(smem + 53248);
  float* red = (float*)(smem + 71680);
  const bf16_t* pj = (const bf16_t*)(p.ws + OFF_BIG);
  gla_gate(p, bc, tok0, h, tid);
  {
    const int d = tid & 63, sg = tid >> 6;
    const float bm = bc[31 * 64 + d];
#pragma unroll 4
    for (int i = 0; i < 16; i++) {
      const int s = sg * 16 + i;
      const float bb = bc[s * 64 + d];
      const float qv = bf2f(pj[(tok0 + s) * 3088 + 1536 + h * 64 + d]);
      const float kv = bf2f(pj[(tok0 + s) * 3088 + 1792 + h * 64 + d]);
      Qg[s * 72 + d] = f2bf(qv * 0.125f * __expf(bb - bm));
      Kg[s * 72 + d] = f2bf(kv * __expf(bm - bb));
    }
  }
  gla_stage_vt(p, Vt, tok0, h, tid);
  {
    const int e = tid >> 1, hf = tid & 1;
    const uint4* sp = (const uint4*)((const bf16_t*)((char*)p.out + OUT_SPT) + (long)task * 8192 + e * 64 + hf * 32);
    uint4* dp = (uint4*)(SpT + e * 72 + hf * 32);
#pragma unroll
    for (int c = 0; c < 4; c++) {
      const uint4 v = sp[c];
      const int d0 = hf * 32 + c * 8;
      uint4 o;
      o.x = pack2(bflo(v.x) * __expf(bc[31 * 64 + d0 + 0]), bfhi(v.x) * __expf(bc[31 * 64 + d0 + 1]));
      o.y = pack2(bflo(v.y) * __expf(bc[31 * 64 + d0 + 2]), bfhi(v.y) * __expf(bc[31 * 64 + d0 + 3]));
      o.z = pack2(bflo(v.z) * __expf(bc[31 * 64 + d0 + 4]), bfhi(v.z) * __expf(bc[31 * 64 + d0 + 5]));
      o.w = pack2(bflo(v.w) * __expf(bc[31 * 64 + d0 + 6]), bfhi(v.w) * __expf(bc[31 * 64 + d0 + 7]));
      dp[c] = o;
    }
  }
  __syncthreads();
  {
    const int mb = w & 1, nb = w >> 1;
    f32x16 a2;
#pragma unroll
    for (int r = 0; r < 16; r++) a2[r] = 0.f;
#pragma unroll
    for (int ks = 0; ks < 4; ks++) {
      const bf16x8 a = lds_frag(Qg, 72, mb * 32, ks * 16, l31, hh);
      const bf16x8 bb = lds_frag(Kg, 72, nb * 32, ks * 16, l31, hh);
      a2 = MFMA32(a, bb, a2);
    }
#pragma unroll
    for (int r = 0; r < 16; r++) {
      const int c = mb * 32 + crow(r, hh), s = nb * 32 + l31;
      att[c * 72 + s] = f2bf((s <= c) ? a2[r] : 0.f);
    }
  }
  __syncthreads();
  f32x16 acc[2];
#pragma unroll
  for (int nb = 0; nb < 2; nb++)
#pragma unroll
    for (int r = 0; r < 16; r++) acc[nb][r] = 0.f;
#pragma unroll
  for (int ks = 0; ks < 4; ks++) {
    const bf16x8 a = lds_frag(Vt, 72, w * 32, ks * 16, l31, hh);
#pragma unroll
    for (int nb = 0; nb < 2; nb++) acc[nb] = MFMA32(a, lds_frag(att, 72, nb * 32, ks * 16, l31, hh), acc[nb]);
  }
#pragma unroll
  for (int ks = 0; ks < 4; ks++) {
    const bf16x8 a = lds_frag(SpT, 72, w * 32, ks * 16, l31, hh);
#pragma unroll
    for (int nb = 0; nb < 2; nb++) acc[nb] = MFMA32(a, lds_frag(Qg, 72, nb * 32, ks * 16, l31, hh), acc[nb]);
  }
#pragma unroll
  for (int nb = 0; nb < 2; nb++) {
    float ss = 0.f;
#pragma unroll
    for (int r = 0; r < 16; r++) ss += acc[nb][r] * acc[nb][r];
    ss += __shfl_xor(ss, 32);
    if (hh == 0) red[w * 64 + nb * 32 + l31] = ss;
  }
  __syncthreads();
  bf16_t* mix = (bf16_t*)(p.ws + OFF_MIX);
#pragma unroll
  for (int nb = 0; nb < 2; nb++) {
    const int c = nb * 32 + l31;
    const float tot = red[c] + red[64 + c] + red[128 + c] + red[192 + c];
    const float rn = rsqrtf(tot * (1.f / 128.f) + 1e-6f);
    const long tok = tok0 + c;
#pragma unroll
    for (int g = 0; g < 4; g++) {
      const int e0 = w * 32 + 8 * g + 4 * hh;
      const float4 gn = *(const float4*)(p.gla_norm + e0);
      const uint2 rr = *(const uint2*)(pj + tok * 3088 + 2560 + h * 128 + e0);
      const float o0 = acc[nb][4 * g + 0] * rn * gn.x * siluf(bflo(rr.x));
      const float o1 = acc[nb][4 * g + 1] * rn * gn.y * siluf(bfhi(rr.x));
      const float o2 = acc[nb][4 * g + 2] * rn * gn.z * siluf(bflo(rr.y));
      const float o3 = acc[nb][4 * g + 3] * rn * gn.w * siluf(bfhi(rr.y));
      *(uint2*)(mix + tok * 1024 + 512 + h * 128 + e0) = make_uint2(pack2(o0, o1), pack2(o2, o3));
    }
  }
  __syncthreads();
}

DI void phase_latent(const Params& p) {
  const int lane = tidx() & 63, w = tidx() >> 6;
  const bf16_t* pj = (const bf16_t*)(p.ws + OFF_P1);
  bf16_t* cqn = (bf16_t*)(p.ws + OFF_CQN);
  bf16_t* ckvn = (bf16_t*)(p.ws + OFF_CKVN);
  bf16_t* kpe = (bf16_t*)(p.ws + OFF_KPE);
  const float2* tab = (const float2*)(p.ws + OFF_ROPE);
  for (int row = blockIdx.x * 8 + w; row < T_; row += gridDim.x * 8) {
    const bf16_t* pr = pj + (long)row * 1440;
    uint4 a = make_uint4(0, 0, 0, 0), c = make_uint4(0, 0, 0, 0);
    if (lane < 48) a = *(const uint4*)(pr + 768 + lane * 8);
    if (lane < 32) c = *(const uint4*)(pr + 1152 + lane * 8);
    float av[8] = {bflo(a.x), bfhi(a.x), bflo(a.y), bfhi(a.y), bflo(a.z), bfhi(a.z), bflo(a.w), bfhi(a.w)};
    float cv[8] = {bflo(c.x), bfhi(c.x), bflo(c.y), bfhi(c.y), bflo(c.z), bfhi(c.z), bflo(c.w), bfhi(c.w)};
    float sa = 0.f, sc = 0.f;
#pragma unroll
    for (int j = 0; j < 8; j++) { sa += av[j] * av[j]; sc += cv[j] * cv[j]; }
    sa = wave_sum(sa); sc = wave_sum(sc);
    const float ra = rsqrtf(sa * (1.f / 384.f) + 1e-6f), rc = rsqrtf(sc * (1.f / 256.f) + 1e-6f);
    if (lane < 48) {
      const float4 g0 = *(const float4*)(p.q_norm + lane * 8), g1 = *(const float4*)(p.q_norm + lane * 8 + 4);
      *(uint4*)(cqn + (long)row * 384 + lane * 8) =
          make_uint4(pack2(av[0] * ra * g0.x, av[1] * ra * g0.y), pack2(av[2] * ra * g0.z, av[3] * ra * g0.w),
                     pack2(av[4] * ra * g1.x, av[5] * ra * g1.y), pack2(av[6] * ra * g1.z, av[7] * ra * g1.w));
    }
    if (lane < 32) {
      const float4 g0 = *(const float4*)(p.kv_norm + lane * 8), g1 = *(const float4*)(p.kv_norm + lane * 8 + 4);
      *(uint4*)(ckvn + (long)row * 256 + lane * 8) =
          make_uint4(pack2(cv[0] * rc * g0.x, cv[1] * rc * g0.y), pack2(cv[2] * rc * g0.z, cv[3] * rc * g0.w),
                     pack2(cv[4] * rc * g1.x, cv[5] * rc * g1.y), pack2(cv[6] * rc * g1.z, cv[7] * rc * g1.w));
    }
    if (lane < 16) {
      const float t1 = bf2f(pr[1408 + lane]), t2 = bf2f(pr[1408 + 16 + lane]);
      const float2 cs = tab[(row & (S_ - 1)) * 16 + lane];
      kpe[(long)row * 32 + lane] = f2bf(t1 * cs.x - t2 * cs.y);
      kpe[(long)row * 32 + 16 + lane] = f2bf(t2 * cs.x + t1 * cs.y);
    }
  }
}

DI void grid_bar(unsigned* ctr, unsigned target) {
  asm volatile("s_waitcnt vmcnt(0)" ::: "memory");
  __syncthreads();
  if (threadIdx.x == 0) {
    __builtin_amdgcn_fence(__ATOMIC_RELEASE, "agent");
    asm volatile("s_waitcnt vmcnt(0)" ::: "memory");
    __hip_atomic_fetch_add(ctr, 1u, __ATOMIC_RELAXED, __HIP_MEMORY_SCOPE_AGENT);
    unsigned spins = 0;
    while (__hip_atomic_load(ctr, __ATOMIC_RELAXED, __HIP_MEMORY_SCOPE_AGENT) < target && ++spins < (1u << 22)) __builtin_amdgcn_s_sleep(1);
    __builtin_amdgcn_fence(__ATOMIC_ACQUIRE, "agent");
    asm volatile("s_waitcnt vmcnt(0)" ::: "memory");
  }
  __syncthreads();
}

DI int a_remap(int tau, int G, int bid) {
  if (G != 256) return tau;
  const int r = tau >> 8, xcd = bid & 7, jx = bid >> 3;
  return (((r >> 1) * 8 + xcd) << 6) + (r & 1) * 32 + jx;
}

__global__ void __launch_bounds__(NTHR, 2) mega_kernel(Params p) {
  __shared__ __attribute__((aligned(16))) char smem[LDS_BYTES];
  cg::grid_group grid = cg::this_grid();
  char* ws = p.ws;
  bf16_t* hbuf = (bf16_t*)(ws + OFF_HBUF);
  bf16_t* mix = (bf16_t*)(ws + OFF_MIX);
  bf16_t* big = (bf16_t*)(ws + OFF_BIG);
  const int G = gridDim.x, bid = blockIdx.x, grp = tidx() >> 8;
  unsigned* bar = (unsigned*)(ws + OFF_BAR);
  unsigned bar_tgt = 0;
#define GBAR() do { bar_tgt += (unsigned)G; grid_bar(bar, bar_tgt); } while (0)

  phase_convert(p, smem);
  phase_rope_table(p);
  phase_rms_first(p.x, p.n_mix_pre, hbuf);
  grid.sync();
  phase_gemm(hbuf, (const bf16_t*)(ws + OFF_W0IN), 3328, 1024, smem, pg8::EpiStoreP{big, 3088, 3088});
  GBAR();
  for (int t = bid; t < 2048; t += G) { if (t < 1024) gla_a_task(p, smem, 2 * t + grp); else attnA_task(p, smem, a_remap(t - 1024, G, bid), 0); }
  GBAR();
  for (int t = bid; t < 128 + 1024; t += G) { if (t < 128) gla_scan_item(p, t); else attnA_task(p, smem, t - 128, 1); }
  GBAR();
  for (int t = bid; t < 2048; t += G) { if (t < 1024) gla_c_task(p, smem, 2 * t + grp); else attnA_task(p, smem, a_remap(t - 1024, G, bid), 2); }
  GBAR();
  phase_gemm(mix, (const bf16_t*)(ws + OFF_W0OUT), 1024, 1024, smem, pg8::EpiStoreP{hbuf, 1024, 1024});
  GBAR();
  phase_resid(p.x, p.out, hbuf, p.n_mix_post, p.n_ffn_pre);
  GBAR();
  phase_gemm(hbuf, (const bf16_t*)(ws + OFF_WGU0), 5632, 1024, smem, pg8::EpiSwigluP{big});
  GBAR();
  phase_gemm(big, (const bf16_t*)(ws + OFF_WDN0), 1024, 2816, smem, pg8::EpiStoreP{hbuf, 1024, 1024});
  GBAR();
  phase_resid(p.out, p.out, hbuf, p.n_ffn_post, p.n_mix_pre + 1024);
  GBAR();
  phase_gemm(hbuf, (const bf16_t*)(ws + OFF_W1IN), 1536, 1024, smem, pg8::EpiStoreP{(bf16_t*)(ws + OFF_P1), 1440, 1440});
  GBAR();
  phase_latent(p);
  GBAR();
  {
    phase_gemm((const bf16_t*)(ws + OFF_CQN), (const bf16_t*)(ws + OFF_WUQ), 768, 384, smem, pg8::EpiStoreP{(bf16_t*)(ws + OFF_Q), 768, 768});
    phase_gemm((const bf16_t*)(ws + OFF_CKVN), (const bf16_t*)(ws + OFF_WUKV), 1024, 256, smem, pg8::EpiStoreP{(bf16_t*)(ws + OFF_KV), 1024, 1024});
  }
  GBAR();
  {
    const bool loc = (G == 256);
    const int xcd = bid & 7, jx = bid >> 3;
    for (int t = bid; t < 512 + 1024; t += G) {
      if (t < 512) {
        const int r = t >> 8;
        attnD_task(p, smem, loc ? ((r * 8 + xcd) * 32 + jx) : t);
      } else {
        const int u = t - 512, r = u >> 8;
        attnC_task(p, smem, loc ? ((((xcd >> 1) * 4 + r) << 6) + (xcd & 1) * 32 + jx) : u);
      }
    }
  }
  GBAR();
  phase_gemm(mix, (const bf16_t*)(ws + OFF_W1OUT), 1024, 1024, smem, pg8::EpiStoreP{hbuf, 1024, 1024});
  GBAR();
  phase_resid(p.out, p.out, hbuf, p.n_mix_post + 1024, p.n_ffn_pre + 1024);
  GBAR();
  phase_gemm(hbuf, (const bf16_t*)(ws + OFF_WGU1), 5632, 1024, smem, pg8::EpiSwigluP{big});
  GBAR();
  phase_gemm(big, (const bf16_t*)(ws + OFF_WDN1), 1024, 2816, smem, pg8::EpiStoreP{hbuf, 1024, 1024});
  GBAR();
  phase_resid(p.out, p.out, hbuf, p.n_ffn_post + 1024, nullptr);
}

extern "C" void kernel_launch(void* const* d_in, const int* in_sizes, int n_in, void* d_out, int out_size, void* d_ws,
                              size_t ws_size, hipStream_t stream) {
  static int grid_blocks = 0;
  if (!grid_blocks) {
    int dev = 0, cus = 0, per_cu = 0;
    hipGetDevice(&dev);
    hipDeviceGetAttribute(&cus, hipDeviceAttributeMultiprocessorCount, dev);
    hipOccupancyMaxActiveBlocksPerMultiprocessor(&per_cu, mega_kernel, NTHR, 0);
    if (per_cu < 1) per_cu = 1;
    grid_blocks = cus * per_cu;
  }
  if (ws_size < (size_t)WS_NEED) { fprintf(stderr, "workspace too small: %zu < %ld\n", ws_size, (long)WS_NEED); return; }
  Params p{};
  const float** f = (const float**)&p;
  for (int i = 0; i < 20; i++) f[i] = (const float*)d_in[i];
  p.out = (float*)d_out;
  p.ws = (char*)d_ws;
  hipMemsetAsync((char*)d_ws + OFF_BAR, 0, 256, stream);
  void* args[] = {&p};
  hipError_t e = hipLaunchCooperativeKernel((void*)mega_kernel, dim3(grid_blocks), dim3(NTHR), args, 0, stream);
  if (e != hipSuccess) fprintf(stderr, "cooperative launch failed: %s (grid %d)\n", hipGetErrorString(e), grid_blocks);
}
```
